# Optimizing an MI355X kernel written in HIP

```python
import math
import jax, jax.numpy as jnp
from jax import lax
import numpy as np

D_MODEL = 2048
BATCH = 4
SEQ = 2048
DEPTH = 2
DEC_BATCH = 128
DEC_SEQ = 8
PAST_LEN = 16384
PAGE_SIZE = 128

POOL_WINDOWS = (2, 4, 8, 16)
POOL_GROUPS = 4
POOL_WIDTH = D_MODEL // 2
POOL_GW = POOL_WIDTH // POOL_GROUPS
POOL_OUT_GW = D_MODEL // POOL_GROUPS
POOL_BUF = max(POOL_WINDOWS) - 1
GLA_HEADS = 4
GLA_DK = D_MODEL // 2 // GLA_HEADS
GLA_DV = D_MODEL // GLA_HEADS
GLA_K = GLA_HEADS * GLA_DK
GLA_V = GLA_HEADS * GLA_DV
GLA_RANK = 16
GLA_TAU = 16.0
GLA_CHUNK = 64
D_FF = 5632
LN_EPS = 1e-5
HEAD_NORM_EPS = 1e-6
ALPHA = (2 * DEPTH) ** 0.25
BETA = (8 * DEPTH) ** -0.25
IN_WIDTH = POOL_WIDTH + 2 * GLA_K + GLA_V + GLA_RANK + GLA_V + 2 * D_MODEL

kernel_name = "hybrid_pool_gla_macaron_deepnorm_step"


def _layer_norm(x, g, b):
    xf = x.astype(jnp.float32)
    mu = jnp.mean(xf, axis=-1, keepdims=True)
    xc = xf - mu
    var = jnp.mean(xc * xc, axis=-1, keepdims=True)
    return (xc * lax.rsqrt(var + LN_EPS) * g + b).astype(x.dtype)


def _swiglu(x, w_in, w_out):
    gate, up = jnp.split(x @ w_in, 2, axis=-1)
    return (jax.nn.silu(gate) * up) @ w_out


def _split_proj(h):
    sizes = (POOL_WIDTH, GLA_K, GLA_K, GLA_V, GLA_RANK, GLA_V, D_MODEL, D_MODEL)
    idx = [int(i) for i in np.cumsum(sizes)[:-1]]
    return jnp.split(h, idx, axis=-1)


def _pool_mixer(u, buf, start, pool_w, pool_scale):
    B, T, P = u.shape
    ext = jnp.concatenate([buf.astype(u.dtype), u], axis=1)
    cs = jnp.cumsum(jnp.concatenate([jnp.zeros((B, 1, P), jnp.float32),
                                     ext.astype(jnp.float32)], axis=1), axis=1)
    off = POOL_BUF + 1
    pos = start + jnp.arange(T)
    outs = []
    for g, w in enumerate(POOL_WINDOWS):
        sl = slice(g * POOL_GW, (g + 1) * POOL_GW)
        win_sum = cs[:, off:off + T, sl] - cs[:, off - w:off - w + T, sl]
        cnt = jnp.minimum(w, pos + 1).astype(jnp.float32)[None, :, None]
        outs.append(win_sum / cnt - u[:, :, sl].astype(jnp.float32))
    pooled = jnp.stack(outs, axis=2).astype(u.dtype)
    y = jnp.einsum('btgc,gcd->btgd', pooled, pool_w).reshape(B, T, D_MODEL) * pool_scale
    return y, ext[:, -POOL_BUF:]


def _gla(q, k, v, loga, S0):
    B, T, H, _ = q.shape
    C = math.gcd(T, GLA_CHUNK)
    n = T // C

    def to_chunks(a):
        return a.astype(jnp.float32).reshape(B, n, C, H, a.shape[-1]).transpose(1, 0, 3, 2, 4)

    mask = jnp.tril(jnp.ones((C, C), bool))[None, None, :, :, None]

    def step(S, inp):
        qc, kc, vc, lc = inp
        b = jnp.cumsum(lc, axis=2)
        o_inter = jnp.einsum('bhik,bhkv->bhiv', qc * jnp.exp(b), S)
        diff = b[:, :, :, None, :] - b[:, :, None, :, :]
        decay = jnp.exp(jnp.where(mask, diff, -jnp.inf))
        A = jnp.einsum('bhik,bhjk,bhijk->bhij', qc, kc, decay)
        o = o_inter + jnp.einsum('bhij,bhjv->bhiv', A, vc)
        b_last = b[:, :, -1:, :]
        S_new = jnp.exp(b_last[:, :, 0, :])[..., None] * S + \
            jnp.einsum('bhjk,bhjv->bhkv', kc * jnp.exp(b_last - b), vc)
        return S_new, o

    S_fin, o = lax.scan(step, S0.astype(jnp.float32),
                        (to_chunks(q), to_chunks(k), to_chunks(v), to_chunks(loga)))
    o = o.transpose(1, 0, 3, 2, 4).reshape(B, T, H, v.shape[-1])
    return o, S_fin.astype(S0.dtype)


def _token_mix(x, pool_buf, gla_state, start, w_in, pool_w, pool_scale, a_up, a_bias,
               head_g, w_gla_out, w_out):
    B, T, _ = x.shape
    u, q, k, v, a_lo, r, g_a, g_b = _split_proj(x @ w_in)
    y_a, new_buf = _pool_mixer(u, pool_buf, start, pool_w, pool_scale)
    loga = jax.nn.log_sigmoid((a_lo @ a_up + a_bias).astype(jnp.float32)) / GLA_TAU
    heads = lambda t, d: t.reshape(B, T, GLA_HEADS, d)
    o, new_S = _gla(heads(q, GLA_DK) * GLA_DK ** -0.5, heads(k, GLA_DK), heads(v, GLA_DV),
                    heads(loga, GLA_DK), gla_state)
    o = o * lax.rsqrt(jnp.mean(o * o, axis=-1, keepdims=True) + HEAD_NORM_EPS)
    o = (o.reshape(B, T, GLA_V) * head_g).astype(x.dtype)
    y_b = (o * jax.nn.silu(r)) @ w_gla_out
    merged = jax.nn.sigmoid(g_a) * y_a + jax.nn.sigmoid(g_b) * y_b
    return merged @ w_out, new_buf, new_S


def _trunk(x, pool_bufs, gla_states, start, ln_g, ln_b, w_ffn_in, w_ffn_out, w_in, pool_w,
           pool_scale, a_up, a_bias, head_g, w_gla_out, w_out):
    new_bufs, new_states = [], []
    for l in range(DEPTH):
        x = _layer_norm(ALPHA * x + 0.5 * _swiglu(x, w_ffn_in[l, 0], w_ffn_out[l, 0]),
                        ln_g[l, 0], ln_b[l, 0])
        m, nb, ns = _token_mix(x, pool_bufs[l], gla_states[l], start, w_in[l], pool_w[l],
                               pool_scale[l], a_up[l], a_bias[l], head_g[l], w_gla_out[l], w_out[l])
        x = _layer_norm(ALPHA * x + m, ln_g[l, 1], ln_b[l, 1])
        x = _layer_norm(ALPHA * x + 0.5 * _swiglu(x, w_ffn_in[l, 1], w_ffn_out[l, 1]),
                        ln_g[l, 2], ln_b[l, 2])
        new_bufs.append(nb)
        new_states.append(ns)
    return x, jnp.stack(new_bufs), jnp.stack(new_states)


def setup_inputs(seed: int = 0) -> dict:
    key = jax.random.key(seed)
    ks = jax.random.split(key, 18)
    nrm = lambda k, shape, scale: jax.random.normal(k, shape, jnp.float32) * scale
    return {
        "x_prompt": nrm(ks[0], (BATCH, SEQ, D_MODEL), 1.0),
        "x_sample": nrm(ks[1], (DEC_BATCH, DEC_SEQ, D_MODEL), 1.0),
        "state_pool": nrm(ks[2], (DEPTH, DEC_BATCH, POOL_BUF, POOL_WIDTH), 1.0),
        "state_gla": nrm(ks[3], (DEPTH, DEC_BATCH, GLA_HEADS, GLA_DK, GLA_DV), 0.5),
        "ln_g": 1.0 + nrm(ks[4], (DEPTH, 3, D_MODEL), 0.02),
        "ln_b": nrm(ks[5], (DEPTH, 3, D_MODEL), 0.01),
        "w_ffn_in": nrm(ks[6], (DEPTH, 2, D_MODEL, 2 * D_FF), D_MODEL ** -0.5),
        "w_ffn_out": nrm(ks[7], (DEPTH, 2, D_FF, D_MODEL), BETA * D_FF ** -0.5),
        "w_in": nrm(ks[8], (DEPTH, D_MODEL, IN_WIDTH), D_MODEL ** -0.5),
        "pool_w": nrm(ks[9], (DEPTH, POOL_GROUPS, POOL_GW, POOL_OUT_GW), POOL_GW ** -0.5),
        "pool_scale": 1.0 + nrm(ks[10], (DEPTH, D_MODEL), 0.02),
        "a_up": nrm(ks[11], (DEPTH, GLA_RANK, GLA_K), GLA_RANK ** -0.5),
        "a_bias": nrm(ks[12], (DEPTH, GLA_K), 0.1),
        "head_g": 1.0 + nrm(ks[13], (DEPTH, GLA_V), 0.02),
        "w_gla_out": nrm(ks[14], (DEPTH, GLA_V, D_MODEL), GLA_V ** -0.5),
        "w_out": nrm(ks[15], (DEPTH, D_MODEL, D_MODEL), BETA * D_MODEL ** -0.5),
    }


def reference(x_prompt, x_sample, state_pool, state_gla, ln_g, ln_b, w_ffn_in, w_ffn_out,
              w_in, pool_w, pool_scale, a_up, a_bias, head_g, w_gla_out, w_out):
    B = x_prompt.shape[0]
    zero_pool = jnp.zeros((DEPTH, B, POOL_BUF, POOL_WIDTH), x_prompt.dtype)
    zero_gla = jnp.zeros((DEPTH, B, GLA_HEADS, GLA_DK, GLA_DV), state_gla.dtype)
    y_prompt, new_pool_prompt, new_gla_prompt = _trunk(
        x_prompt, zero_pool, zero_gla, 0, ln_g, ln_b, w_ffn_in, w_ffn_out, w_in, pool_w,
        pool_scale, a_up, a_bias, head_g, w_gla_out, w_out)
    y_sample, new_pool_sample, new_gla_sample = _trunk(
        x_sample, state_pool, state_gla, PAST_LEN, ln_g, ln_b, w_ffn_in, w_ffn_out, w_in, pool_w,
        pool_scale, a_up, a_bias, head_g, w_gla_out, w_out)
    return (y_prompt, y_sample, new_pool_prompt, new_gla_prompt, new_pool_sample, new_gla_sample)
```

```cpp
#include <hip/hip_runtime.h>
#include <cstdio>
#include <cstdint>

#ifndef MK_PER_PHASE
#define MK_PER_PHASE 0
#endif

namespace pg8 {
#define PG8_LAS __attribute__((address_space(3)))
typedef unsigned short bf16_t;
typedef short bf16x8 __attribute__((ext_vector_type(8)));
typedef float f32x4 __attribute__((ext_vector_type(4)));
typedef unsigned u32x4 __attribute__((ext_vector_type(4)));
typedef unsigned u32x2 __attribute__((ext_vector_type(2)));
constexpr int BM = 256, BK = 64, HALF = 128, HTB = HALF * BK * 2  , STAGE_BYTES = 8 * HTB, NXCD = 8, WGM = 8;

__host__ __device__ __forceinline__ int lds_byte(int r, int c) { const int st = (r >> 4) * 2 + (c >> 5), rr = r & 15, cc = c & 31, ob = rr * 64 + cc * 2; return st * 1024 + (ob ^ (((ob >> 9) & 1) << 5)); }
__host__ __device__ __forceinline__ void stage_rc(int b, int& R, int& C) { const int st = b / 1024, sb = b % 1024, swz = sb ^ (((sb >> 9) & 1) << 5); R = (st >> 1) * 16 + swz / 64; C = (st & 1) * 32 + (swz % 64) / 2; }
__host__ __device__ __forceinline__ int perm32(int rho) { const int n = rho >> 4, i = rho & 15; return 8 * (i >> 2) + 4 * n + (i & 3); }

struct Unit { int pm, pn; };
struct Gemm { const bf16_t* A; const bf16_t* Bt; int M, N, K, lda, ldb, a_shift, a_mul; };

struct StaticOrder {
    int nM, nN, nwg, G, c;
    __host__ __device__ void init(int M, int N, int G_, int c_) { nM = M / BM; nN = N / BM; nwg = nM * nN; G = G_; c = c_; }
    __host__ __device__ bool next(int i, Unit& u) const {
        const long L = (long)i * G + c; if (L >= nwg) return false;
        int wgid = (int)L; { const int q = nwg / NXCD, r = nwg % NXCD, xcd = wgid % NXCD, off = wgid / NXCD; wgid = (xcd < r ? xcd * (q + 1) : r * (q + 1) + (xcd - r) * q) + off; }
        const int nig = WGM * nN, gid = wgid / nig, fm = gid * WGM, gsz = (nM - fm) < WGM ? (nM - fm) : WGM;
        u.pm = fm + ((wgid % nig) % gsz); u.pn = (wgid % nig) / gsz; return true;
    }
    __device__ __forceinline__ void a_ready(const Unit&) const {}
    __device__ __forceinline__ void done(const Unit&) const {}
};

__device__ __forceinline__ unsigned cvt_pk_bf16(float lo, float hi) { unsigned r; asm volatile("v_cvt_pk_bf16_f32 %0, %1, %2" : "=v"(r) : "v"(lo), "v"(hi)); return r; }
__device__ __forceinline__ float bf_lo(unsigned w) { return __uint_as_float(w << 16); }
__device__ __forceinline__ float bf_hi(unsigned w) { return __uint_as_float(w & 0xffff0000u); }
__device__ __forceinline__ float sigmoidf_(float x) { return __builtin_amdgcn_rcpf(1.0f + __expf(-x)); }
__device__ __forceinline__ float siluf_(float x) { return x * sigmoidf_(x); }


struct EpiBf16 {
    static constexpr bool PERM = true;
    bf16_t* O; int ldc;
    __device__ __forceinline__ void operator()(const f32x4 (&acc)[2][2][4][2], const Unit& u, int wr, int wc, int fr, int fq) const {
        const int row0 = u.pm * BM + wr * 64 + fr, col0 = u.pn * BM + wc * 32 + 8 * fq;
#pragma unroll
        for (int ai = 0; ai < 2; ++ai)
#pragma unroll
            for (int m = 0; m < 4; ++m) { bf16_t* rowp = O + (size_t)(row0 + ai * HALF + m * 16) * ldc + col0;
#pragma unroll
                for (int bj = 0; bj < 2; ++bj) { const f32x4 v0 = acc[ai][bj][m][0], v1 = acc[ai][bj][m][1];
                    u32x4 w; w.x = cvt_pk_bf16(v0[0], v0[1]); w.y = cvt_pk_bf16(v0[2], v0[3]); w.z = cvt_pk_bf16(v1[0], v1[1]); w.w = cvt_pk_bf16(v1[2], v1[3]);
                    *(u32x4*)(rowp + bj * HALF) = w; } }
    }
};
struct EpiSwiGLU {
    static constexpr bool PERM = true;
    bf16_t* O; int ldc;
    __device__ __forceinline__ void operator()(const f32x4 (&acc)[2][2][4][2], const Unit& u, int wr, int wc, int fr, int fq) const {
        const int row0 = u.pm * BM + wr * 64 + fr, col0 = u.pn * HALF + wc * 32 + 8 * fq;
#pragma unroll
        for (int ai = 0; ai < 2; ++ai)
#pragma unroll
            for (int m = 0; m < 4; ++m) { bf16_t* rowp = O + (size_t)(row0 + ai * HALF + m * 16) * ldc + col0;
                float o[8];
#pragma unroll
                for (int n = 0; n < 2; ++n)
#pragma unroll
                    for (int e = 0; e < 4; ++e) o[4 * n + e] = siluf_(acc[ai][0][m][n][e]) * acc[ai][1][m][n][e];
                u32x4 w; w.x = cvt_pk_bf16(o[0], o[1]); w.y = cvt_pk_bf16(o[2], o[3]); w.z = cvt_pk_bf16(o[4], o[5]); w.w = cvt_pk_bf16(o[6], o[7]);
                *(u32x4*)rowp = w; }
    }
};
struct EpiResid {
    static constexpr bool PERM = false;
    float* Y; const float* resA; const float* resB; int split; float alpha, s;
    __device__ __forceinline__ void operator()(const f32x4 (&acc)[2][2][4][2], const Unit& u, int wr, int wc, int fr, int fq) const {
        const int row0 = u.pm * BM + wr * 64 + fr, col0 = u.pn * BM + wc * 32 + 4 * fq;
        const float* rbase = (u.pm * BM < split) ? resA + (size_t)row0 * 2048 : resB + (size_t)(row0 - split) * 2048;
#pragma unroll
        for (int ai = 0; ai < 2; ++ai)
#pragma unroll
            for (int m = 0; m < 4; ++m) { const size_t ro = (size_t)(ai * HALF + m * 16) * 2048 + col0; float* yp = Y + (size_t)row0 * 2048 + ro; const float* rp = rbase + ro;
#pragma unroll
                for (int bj = 0; bj < 2; ++bj)
#pragma unroll
                    for (int n = 0; n < 2; ++n) { const f32x4 r = *(const f32x4*)(rp + bj * HALF + n * 16); *(f32x4*)(yp + bj * HALF + n * 16) = r * alpha + acc[ai][bj][m][n] * s; }
                asm volatile("" ::: "memory"); }
    }
};
struct EpiUqka {
    static constexpr bool PERM = true;
    bf16_t* HQ; float* ALO;
    __device__ __forceinline__ void operator()(const f32x4 (&acc)[2][2][4][2], const Unit& u, int wr, int wc, int fr, int fq) const {
        const int row0 = u.pm * BM + wr * 64 + fr;
        if (u.pn < 12) {
            const float sc = (u.pn >= 4 && u.pn < 8) ? 0.0625f : 1.0f; const int col0 = u.pn * BM + wc * 32 + 8 * fq;
#pragma unroll
            for (int ai = 0; ai < 2; ++ai)
#pragma unroll
                for (int m = 0; m < 4; ++m) { bf16_t* rowp = HQ + (size_t)(row0 + ai * HALF + m * 16) * 3072 + col0;
#pragma unroll
                    for (int bj = 0; bj < 2; ++bj) { const f32x4 v0 = acc[ai][bj][m][0] * sc, v1 = acc[ai][bj][m][1] * sc;
                        u32x4 w; w.x = cvt_pk_bf16(v0[0], v0[1]); w.y = cvt_pk_bf16(v0[2], v0[3]); w.z = cvt_pk_bf16(v1[0], v1[1]); w.w = cvt_pk_bf16(v1[2], v1[3]);
                        *(u32x4*)(rowp + bj * HALF) = w; } }
        } else if (wc == 0 && fq < 2) {
#pragma unroll
            for (int ai = 0; ai < 2; ++ai)
#pragma unroll
                for (int m = 0; m < 4; ++m) { float* rowp = ALO + (size_t)(row0 + ai * HALF + m * 16) * 16 + 8 * fq;
                    *(f32x4*)rowp = acc[ai][0][m][0]; *(f32x4*)(rowp + 4) = acc[ai][0][m][1]; }
        }
    }
};
struct EpiRgg {
    static constexpr bool PERM = true;
    bf16_t* HR;
    __device__ __forceinline__ void operator()(const f32x4 (&acc)[2][2][4][2], const Unit& u, int wr, int wc, int fr, int fq) const {
        const int row0 = u.pm * BM + wr * 64 + fr, col0 = u.pn * BM + wc * 32 + 8 * fq; const bool is_r = u.pn < 8;
#pragma unroll
        for (int ai = 0; ai < 2; ++ai)
#pragma unroll
            for (int m = 0; m < 4; ++m) { bf16_t* rowp = HR + (size_t)(row0 + ai * HALF + m * 16) * 6144 + col0;
#pragma unroll
                for (int bj = 0; bj < 2; ++bj) { float o[8];
#pragma unroll
                    for (int n = 0; n < 2; ++n)
#pragma unroll
                        for (int e = 0; e < 4; ++e) { const float x = acc[ai][bj][m][n][e], sg = sigmoidf_(x); o[4 * n + e] = is_r ? x * sg : sg; }
                    u32x4 w; w.x = cvt_pk_bf16(o[0], o[1]); w.y = cvt_pk_bf16(o[2], o[3]); w.z = cvt_pk_bf16(o[4], o[5]); w.w = cvt_pk_bf16(o[6], o[7]);
                    *(u32x4*)(rowp + bj * HALF) = w; } }
    }
};
struct EpiPool {
    static constexpr bool PERM = true;
    bf16_t* YA; const bf16_t* HR; const float* ps;
    __device__ __forceinline__ void operator()(const f32x4 (&acc)[2][2][4][2], const Unit& u, int wr, int wc, int fr, int fq) const {
        const int row0 = u.pm * BM + wr * 64 + fr, col0 = u.pn * BM + wc * 32 + 8 * fq;
#pragma unroll
        for (int bj = 0; bj < 2; ++bj) { const f32x4 pv0 = *(const f32x4*)(ps + col0 + bj * HALF), pv1 = *(const f32x4*)(ps + col0 + bj * HALF + 4);
#pragma unroll
        for (int ai = 0; ai < 2; ++ai)
#pragma unroll
            for (int m = 0; m < 4; ++m) { const size_t r = (size_t)(row0 + ai * HALF + m * 16);
                { const u32x4 g = *(const u32x4*)(HR + r * 6144 + 2048 + col0 + bj * HALF);
                    const f32x4 v0 = acc[ai][bj][m][0] * pv0, v1 = acc[ai][bj][m][1] * pv1;
                    u32x4 w; w.x = cvt_pk_bf16(v0[0] * bf_lo(g.x), v0[1] * bf_hi(g.x)); w.y = cvt_pk_bf16(v0[2] * bf_lo(g.y), v0[3] * bf_hi(g.y));
                    w.z = cvt_pk_bf16(v1[0] * bf_lo(g.z), v1[1] * bf_hi(g.z)); w.w = cvt_pk_bf16(v1[2] * bf_lo(g.w), v1[3] * bf_hi(g.w));
                    *(u32x4*)(YA + r * 2048 + col0 + bj * HALF) = w; }
                if (m & 1) asm volatile("" ::: "memory"); } }
    }
};
struct EpiMerge {
    static constexpr bool PERM = true;
    bf16_t* MG; const bf16_t* YA; const bf16_t* HR;
    __device__ __forceinline__ void operator()(const f32x4 (&acc)[2][2][4][2], const Unit& u, int wr, int wc, int fr, int fq) const {
        const int row0 = u.pm * BM + wr * 64 + fr, col0 = u.pn * BM + wc * 32 + 8 * fq;
#pragma unroll
        for (int ai = 0; ai < 2; ++ai)
#pragma unroll
            for (int m = 0; m < 4; ++m) { const size_t r = (size_t)(row0 + ai * HALF + m * 16);
#pragma unroll
                for (int bj = 0; bj < 2; ++bj) { const u32x4 g = *(const u32x4*)(HR + r * 6144 + 4096 + col0 + bj * HALF); const u32x4 y = *(const u32x4*)(YA + r * 2048 + col0 + bj * HALF);
                    const f32x4 v0 = acc[ai][bj][m][0], v1 = acc[ai][bj][m][1];
                    u32x4 w; w.x = cvt_pk_bf16(bf_lo(y.x) + v0[0] * bf_lo(g.x), bf_hi(y.x) + v0[1] * bf_hi(g.x)); w.y = cvt_pk_bf16(bf_lo(y.y) + v0[2] * bf_lo(g.y), bf_hi(y.y) + v0[3] * bf_hi(g.y));
                    w.z = cvt_pk_bf16(bf_lo(y.z) + v1[0] * bf_lo(g.z), bf_hi(y.z) + v1[1] * bf_hi(g.z)); w.w = cvt_pk_bf16(bf_lo(y.w) + v1[2] * bf_lo(g.w), bf_hi(y.w) + v1[3] * bf_hi(g.w));
                    *(u32x4*)(MG + r * 2048 + col0 + bj * HALF) = w; }
                asm volatile("" ::: "memory"); }
    }
};

template <class Epi, class Sched, bool ALIGN_EPI = true, bool SP2 = true>
__device__ __forceinline__ void gemm_phase(PG8_LAS unsigned char* lds, const Gemm g, const Sched& S, const Epi& E) {
    int tid_ = threadIdx.x; asm volatile("" : "+v"(tid_));
    const int tid = tid_, wid = __builtin_amdgcn_readfirstlane(tid >> 6), lane = tid & 63, wr = wid >> 2, wc = wid & 3, fr = lane & 15, fq = lane >> 4;
    const int K = g.K, nt = K / BK;
    unsigned voffA[2], voffB[2];
#pragma unroll
    for (int i = 0; i < 2; ++i) { int R, C; stage_rc(tid * 16 + i * 8192, R, C); const int Rb = Epi::PERM ? ((R & ~31) + perm32(R & 31)) : R;
        voffA[i] = (unsigned)(R * g.lda + C) * 2u; voffB[i] = (unsigned)(Rb * g.ldb + C) * 2u; }
    const size_t kstep = (size_t)(BK * 2);
    const size_t hstepA = (size_t)HALF * g.lda * 2, hstepB = (size_t)HALF * g.ldb * 2;
    const size_t tstepA = 2 * hstepA, tstepB = 2 * hstepB;
    const unsigned ldsw = (unsigned)wid * 1024u;
    const int aoff = lds_byte(wr * 64 + fr, fq * 8), boff = lds_byte(wc * 32 + fr, fq * 8);
#define PG8_SA(b, h) (((b) * 2 + (h)) * HTB)
#define PG8_SB(b, h) ((4 + (b) * 2 + (h)) * HTB)
#define PG8_STAGE(bufoff, gbase, voff) do { _Pragma("unroll") for (int _i = 0; _i < 2; ++_i) \
        __builtin_amdgcn_global_load_lds((const unsigned*)((const char*)(gbase) + (voff)[_i]), (PG8_LAS unsigned*)(lds + (bufoff) + ldsw + _i * 8192), 16, 0, 0); } while (0)
#define PG8_LDA(dst, b, h) do { _Pragma("unroll") for (int m = 0; m < 4; ++m) _Pragma("unroll") for (int k = 0; k < 2; ++k) dst[m][k] = *(const PG8_LAS bf16x8*)(lds + PG8_SA(b, h) + aoff + m * 2048 + k * 1024); } while (0)
#define PG8_LDB(dst, b, h) do { _Pragma("unroll") for (int n = 0; n < 2; ++n) _Pragma("unroll") for (int k = 0; k < 2; ++k) dst[n][k] = *(const PG8_LAS bf16x8*)(lds + PG8_SB(b, h) + boff + n * 2048 + k * 1024); } while (0)
#define PG8_MMA(ai, bj, At, Bt) do { __builtin_amdgcn_s_setprio(1); _Pragma("unroll") for (int m = 0; m < 4; ++m) _Pragma("unroll") for (int n = 0; n < 2; ++n) _Pragma("unroll") for (int k = 0; k < 2; ++k) \
        acc[ai][bj][m][n] = __builtin_amdgcn_mfma_f32_16x16x32_bf16(Bt[n][k], At[m][k], acc[ai][bj][m][n], 0, 0, 0); __builtin_amdgcn_s_setprio(0); } while (0)
#define PG8_WAIT_V(n) asm volatile("s_waitcnt vmcnt(" #n ")" ::: "memory")
#define PG8_WAIT_L(n) asm volatile("s_waitcnt lgkmcnt(" #n ")" ::: "memory")
#define PG8_BAR __builtin_amdgcn_s_barrier()
#define PG8_SCHED __builtin_amdgcn_sched_barrier(0)
#define PG8_APTR(u) ((const char*)g.A + (size_t)(u).pm * tstepA + (size_t)(((u).pn >> g.a_shift) * g.a_mul) * 2)
#define PG8_BPTR(u) ((const char*)g.Bt + (size_t)(u).pn * tstepB)
    Unit cur, nxt; int ui = 0;
    if (!S.next(0, cur)) return;
    f32x4 acc[2][2][4][2];
#pragma unroll
    for (int a = 0; a < 2; ++a)
#pragma unroll
        for (int b = 0; b < 2; ++b)
#pragma unroll
            for (int m = 0; m < 4; ++m)
#pragma unroll
                for (int n = 0; n < 2; ++n) acc[a][b][m][n] = (f32x4){0.f, 0.f, 0.f, 0.f};
    bf16x8 At[4][2], B0[2][2], B1[2][2];
    const char* cA = PG8_APTR(cur); const char* cB = PG8_BPTR(cur);
    S.a_ready(cur);
    if constexpr (SP2) {
        PG8_STAGE(PG8_SB(0, 0), cB, voffB); PG8_STAGE(PG8_SB(0, 1), cB + hstepB, voffB); PG8_STAGE(PG8_SA(0, 0), cA, voffA); PG8_STAGE(PG8_SA(0, 1), cA + hstepA, voffA);
        if (wr == 1) PG8_BAR;
        PG8_WAIT_V(2); PG8_BAR;
        PG8_STAGE(PG8_SB(1, 0), cB + kstep, voffB); PG8_STAGE(PG8_SA(1, 0), cA + kstep, voffA); PG8_STAGE(PG8_SB(1, 1), cB + hstepB + kstep, voffB);
        PG8_WAIT_V(6); PG8_BAR;
    } else {
        PG8_STAGE(PG8_SB(0, 0), cB, voffB); PG8_STAGE(PG8_SA(0, 0), cA, voffA); PG8_STAGE(PG8_SB(0, 1), cB + hstepB, voffB); PG8_STAGE(PG8_SA(0, 1), cA + hstepA, voffA);
        if (wr == 1) PG8_BAR;
        PG8_WAIT_V(4); PG8_BAR;
        PG8_STAGE(PG8_SB(1, 0), cB + kstep, voffB); PG8_STAGE(PG8_SA(1, 0), cA + kstep, voffA); PG8_STAGE(PG8_SB(1, 1), cB + hstepB + kstep, voffB);
        PG8_WAIT_V(6); PG8_BAR;
    }
    for (;;) {
        const bool has_next = S.next(ui + 1, nxt);
        const char* nA = has_next ? PG8_APTR(nxt) : cA; const char* nB = has_next ? PG8_BPTR(nxt) : cB;
        for (int t = 0; t < nt; t += 2) {
            const bool last = (t == nt - 2);
            const char* a1 = cA + (size_t)(t + 1) * kstep;
            const char* a2 = last ? nA : cA + (size_t)(t + 2) * kstep; const char* b2 = last ? nB : cB + (size_t)(t + 2) * kstep;
            const char* a3 = a2 + kstep; const char* b3 = b2 + kstep;
            if (last && has_next) S.a_ready(nxt);
            if constexpr (SP2) {
            PG8_LDB(B0, 0, 0); PG8_LDB(B1, 0, 1); PG8_SCHED; PG8_LDA(At, 0, 0); PG8_STAGE(PG8_SA(1, 1), a1 + hstepA, voffA);
            PG8_WAIT_V(8); PG8_WAIT_L(0); PG8_BAR; PG8_MMA(0, 0, At, B0); PG8_MMA(0, 1, At, B1); PG8_BAR; PG8_SCHED;
            PG8_LDA(At, 0, 1); PG8_STAGE(PG8_SB(0, 0), b2, voffB); PG8_STAGE(PG8_SB(0, 1), b2 + hstepB, voffB); PG8_STAGE(PG8_SA(0, 0), a2, voffA);
            PG8_WAIT_V(8); PG8_WAIT_L(0); PG8_BAR; PG8_MMA(1, 0, At, B0); PG8_MMA(1, 1, At, B1); PG8_BAR; PG8_SCHED;
            PG8_LDB(B0, 1, 0); PG8_LDB(B1, 1, 1); PG8_SCHED; PG8_LDA(At, 1, 0); PG8_STAGE(PG8_SA(0, 1), a2 + hstepA, voffA);
            PG8_WAIT_V(8); PG8_WAIT_L(0); PG8_BAR; PG8_MMA(0, 0, At, B0); PG8_MMA(0, 1, At, B1); PG8_BAR; PG8_SCHED;
            PG8_LDA(At, 1, 1); PG8_STAGE(PG8_SB(1, 0), b3, voffB); PG8_STAGE(PG8_SB(1, 1), b3 + hstepB, voffB); PG8_STAGE(PG8_SA(1, 0), a3, voffA);
            PG8_WAIT_V(8); PG8_WAIT_L(0); PG8_BAR; PG8_MMA(1, 0, At, B0); PG8_MMA(1, 1, At, B1); PG8_BAR; PG8_SCHED;
            } else {
            PG8_LDB(B0, 0, 0); PG8_SCHED; PG8_LDA(At, 0, 0); PG8_STAGE(PG8_SA(1, 1), a1 + hstepA, voffA);
            PG8_WAIT_L(8); PG8_BAR; PG8_WAIT_L(0); PG8_MMA(0, 0, At, B0); PG8_BAR; PG8_SCHED;
            PG8_LDB(B1, 0, 1); PG8_STAGE(PG8_SB(0, 0), b2, voffB);
            PG8_BAR; PG8_WAIT_L(0); PG8_MMA(0, 1, At, B1); PG8_BAR;
            PG8_LDA(At, 0, 1); PG8_STAGE(PG8_SA(0, 0), a2, voffA);
            PG8_BAR; PG8_WAIT_L(0); PG8_MMA(1, 0, At, B0); PG8_BAR; PG8_SCHED;
            PG8_STAGE(PG8_SB(0, 1), b2 + hstepB, voffB);
            PG8_WAIT_V(6); PG8_BAR; PG8_MMA(1, 1, At, B1); PG8_BAR;
            PG8_LDB(B0, 1, 0); PG8_SCHED; PG8_LDA(At, 1, 0); PG8_STAGE(PG8_SA(0, 1), a2 + hstepA, voffA);
            PG8_WAIT_L(8); PG8_BAR; PG8_WAIT_L(0); PG8_MMA(0, 0, At, B0); PG8_BAR; PG8_SCHED;
            PG8_LDB(B1, 1, 1); PG8_STAGE(PG8_SB(1, 0), b3, voffB);
            PG8_BAR; PG8_WAIT_L(0); PG8_MMA(0, 1, At, B1); PG8_BAR;
            PG8_LDA(At, 1, 1); PG8_STAGE(PG8_SA(1, 0), a3, voffA);
            PG8_BAR; PG8_WAIT_L(0); PG8_MMA(1, 0, At, B0); PG8_BAR; PG8_SCHED;
            PG8_STAGE(PG8_SB(1, 1), b3 + hstepB, voffB);
            PG8_WAIT_V(6); PG8_BAR; PG8_MMA(1, 1, At, B1); PG8_BAR;
            }
        }
        if constexpr (ALIGN_EPI) { if (wr == 0) PG8_BAR; }
        E(acc, cur, wr, wc, fr, fq); S.done(cur);
        if (!has_next) break;
#pragma unroll
        for (int a = 0; a < 2; ++a)
#pragma unroll
            for (int b = 0; b < 2; ++b)
#pragma unroll
                for (int m = 0; m < 4; ++m)
#pragma unroll
                    for (int n = 0; n < 2; ++n) acc[a][b][m][n] = (f32x4){0.f, 0.f, 0.f, 0.f};
        cur = nxt; cA = nA; cB = nB; ++ui;
        if constexpr (ALIGN_EPI) { if (wr == 1) PG8_BAR; }
    }
    PG8_WAIT_V(0);
    if constexpr (!ALIGN_EPI) { if (wr == 0) PG8_BAR; }
    PG8_BAR;
#undef PG8_SA
#undef PG8_SB
#undef PG8_STAGE
#undef PG8_LDA
#undef PG8_LDB
#undef PG8_MMA
#undef PG8_WAIT_V
#undef PG8_WAIT_L
#undef PG8_BAR
#undef PG8_SCHED
#undef PG8_APTR
#undef PG8_BPTR
}
}

constexpr int NWAVES = 8;
constexpr int D = 2048, MP = 8192, MS = 1024, M = MP + MS;
constexpr int SEQ = 2048, NB = 4, DECB = 128, DECT = 8;
constexpr int FF = 5632, FF2 = 2 * FF, INW = 11280;
constexpr int PW = 1024, PBUF = 15;
constexpr int GH = 4, DK = 256, DV = 512, GK = 1024, GV = 2048, RANK = 16;
constexpr float LN_EPS = 1e-5f, HN_EPS = 1e-6f;
constexpr float ALPHA = 1.41421356237309515f;
constexpr int NCHUNK = 256;

constexpr size_t O_Y = 0, O_NPP = (size_t)M * D, O_NGP = O_NPP + (size_t)2 * NB * PBUF * PW, O_NPS = O_NGP + (size_t)2 * NB * GH * DK * DV,
                 O_NGS = O_NPS + (size_t)2 * DECB * PBUF * PW, O_END = O_NGS + (size_t)2 * DECB * GH * DK * DV;

constexpr size_t MiB = 1u << 20;
constexpr size_t WS_CTL = 0, CTL_ZERO_BYTES = 1 * MiB;
constexpr size_t SZ_WFI = (size_t)FF2 * D * 2, SZ_WFO = (size_t)D * FF * 2, SZ_WUQKA = (size_t)3328 * D * 2, SZ_WV = (size_t)D * D * 2, SZ_WRGG = (size_t)6144 * D * 2,
                 SZ_WPOOL = (size_t)2048 * 256 * 2, SZ_WSQ = (size_t)D * D * 2;
constexpr size_t WS_WFI = 1 * MiB;
constexpr size_t WS_WFO = WS_WFI + 4 * SZ_WFI;
constexpr size_t WS_WUQKA = WS_WFO + 4 * SZ_WFO;
constexpr size_t WS_WV = WS_WUQKA + 2 * SZ_WUQKA;
constexpr size_t WS_WRGG = WS_WV + 2 * SZ_WV;
constexpr size_t WS_WPOOL = WS_WRGG + 2 * SZ_WRGG;
constexpr size_t WS_WGO = WS_WPOOL + 2 * SZ_WPOOL;
constexpr size_t WS_WO = WS_WGO + 2 * SZ_WSQ;
constexpr size_t WS_XF = WS_WO + 2 * SZ_WSQ;
constexpr size_t WS_XB = WS_XF + (size_t)M * D * 4;
constexpr size_t WS_Y = WS_XB + (size_t)M * D * 2;
constexpr size_t WS_ACT = WS_Y + (size_t)M * D * 4;
constexpr size_t WS_HQ = WS_ACT + (size_t)M * FF * 2;
constexpr size_t WS_HR = WS_HQ + (size_t)M * 3072 * 2;
constexpr size_t WS_VT = WS_HR + (size_t)M * 6144 * 2;
constexpr size_t WS_ALO = WS_VT + (size_t)M * D * 2;
constexpr size_t WS_POOLED = WS_ALO + 1 * MiB;
constexpr size_t WS_QT = WS_POOLED + (size_t)M * 1024 * 2;
constexpr size_t WS_KT = WS_QT + (size_t)M * 1024 * 2;
constexpr size_t WS_KHT = WS_KT + (size_t)M * 1024 * 2;
constexpr size_t WS_GDEC = WS_KHT + (size_t)M * 1024 * 2;
constexpr size_t WS_ORAW = WS_GDEC + 1 * MiB;
constexpr size_t WS_OG = WS_ORAW + (size_t)M * D * 4;
constexpr size_t WS_YA = WS_OG + (size_t)M * D * 2;
constexpr size_t WS_MG = WS_YA + (size_t)M * D * 2;
constexpr size_t WS_END = WS_MG + (size_t)M * D * 2;
constexpr int CW_BAR = 4096;
constexpr int CW_QUEUE = 16384;

constexpr int RING_BYTES = 135168;
constexpr int LDSCTL_OFF = RING_BYTES, MISC_OFF = LDSCTL_OFF + 320;
constexpr int LDS_BYTES = 147456;

#define GAS __attribute__((address_space(1)))
#define LAS __attribute__((address_space(3)))
typedef unsigned short bf16;
typedef unsigned v4u __attribute__((ext_vector_type(4)));
typedef unsigned v2u __attribute__((ext_vector_type(2)));
typedef float f32x4 __attribute__((ext_vector_type(4)));
typedef float f32x2 __attribute__((ext_vector_type(2)));
typedef short bf16x8 __attribute__((ext_vector_type(8)));
typedef short bf16x4 __attribute__((ext_vector_type(4)));
typedef GAS unsigned gu32;
#define RLX_AGENT __ATOMIC_RELAXED, __HIP_MEMORY_SCOPE_AGENT
#define LDS_WAIT() asm volatile("s_waitcnt lgkmcnt(0)" ::: "memory")
#define VM_WAIT() asm volatile("s_waitcnt vmcnt(0)" ::: "memory")
__device__ __forceinline__ unsigned f2bf(float f) { unsigned u = __builtin_bit_cast(unsigned, f); return (u + 0x7fffu + ((u >> 16) & 1u)) >> 16; }
__device__ __forceinline__ unsigned pk2(float lo, float hi) { return pg8::cvt_pk_bf16(lo, hi); }
__device__ __forceinline__ float bf2f(bf16 b) { return __uint_as_float(((unsigned)b) << 16); }

#define XB_TMO      128
#define XB_XCNT(j)  (256  + 64 * (j))
#define XB_XSUB(j)  (1280 + 64 * (j))
#define XB_XGEN(j)  (2304 + 64 * (j))
#define XB_TOP      3328
#define XB_TOPGEN   3392
#define XCD_BAR_WORDS 3456
#define XB_SPIN_CAP (1u << 20)

__device__ __forceinline__ unsigned xb_ld(unsigned* p)              { return __hip_atomic_load(p, __ATOMIC_RELAXED, __HIP_MEMORY_SCOPE_AGENT); }
__device__ __forceinline__ unsigned xb_add(unsigned* p, unsigned v) { return __hip_atomic_fetch_add(p, v, __ATOMIC_RELAXED, __HIP_MEMORY_SCOPE_AGENT); }
__device__ __forceinline__ unsigned xb_xcc_id() { return (unsigned)__builtin_amdgcn_s_getreg((3 << 11) | 20) & 0xFu; }
#define XB_SPIN(cond, bar) do { unsigned _sp = 0; while (cond) { __builtin_amdgcn_s_sleep(1); \
    if ((++_sp & 255u) == 0u) { if (xb_ld(&(bar)[XB_TMO])) break; if (_sp > XB_SPIN_CAP) { atomicAdd(&(bar)[XB_TMO], 1u); break; } } } } while (0)

struct XcdBarrier { unsigned* bar; unsigned x; volatile LAS unsigned* st; };

__device__ __forceinline__ XcdBarrier xcd_barrier_post(unsigned* bar, volatile LAS unsigned* st) {
    XcdBarrier b; b.bar = bar; b.x = xb_xcc_id(); b.st = st;
    if (threadIdx.x == 0) (void)xb_add(&bar[XB_XCNT(b.x)], 1u);
    return b;
}
__device__ __forceinline__ void xcd_barrier_complete(unsigned* bar, unsigned x, unsigned& nloc, unsigned& nx) {
    const unsigned G = gridDim.x * gridDim.y * gridDim.z;
    unsigned sum, cnt, mine, sp = 0u;
    for (;;) {
        sum = 0u; cnt = 0u; mine = 0u;
#pragma unroll
        for (unsigned j = 0; j < 16; ++j) { const unsigned c = xb_ld(&bar[XB_XCNT(j)]); sum += c; cnt += (c > 0u) ? 1u : 0u; mine = (j == x) ? c : mine; }
        if (sum == G) break;
        __builtin_amdgcn_s_sleep(1);
        if ((++sp & 255u) == 0u) { if (xb_ld(&bar[XB_TMO])) break; if (sp > XB_SPIN_CAP) { atomicAdd(&bar[XB_TMO], 1u); break; } }
    }
    nloc = mine > 0u ? mine : 1u; nx = cnt > 0u ? cnt : 1u;
}
__device__ __forceinline__ void xcd_barrier(const XcdBarrier& b) {
    asm volatile("s_waitcnt vmcnt(0)" ::: "memory");
    __syncthreads();
    if (threadIdx.x == 0) {
        unsigned* bar = b.bar;
        __builtin_amdgcn_s_waitcnt(0);
        unsigned nloc = b.st[0], nx = b.st[1];
        if (nloc == 0u) { xcd_barrier_complete(bar, b.x, nloc, nx); b.st[0] = nloc; b.st[1] = nx; }
        const unsigned old = xb_add(&bar[XB_XSUB(b.x)], 1u);
        const unsigned gen = old / nloc;
        if (old + 1u == (gen + 1u) * nloc) {
            __builtin_amdgcn_fence(__ATOMIC_RELEASE, "agent");
            asm volatile("s_waitcnt vmcnt(0)" ::: "memory");
            const unsigned og = xb_add(&bar[XB_TOP], 1u);
            const unsigned tg = og / nx;
            if (og + 1u == (tg + 1u) * nx) xb_add(&bar[XB_TOPGEN], 1u);
            else XB_SPIN(xb_ld(&bar[XB_TOPGEN]) == tg, bar);
            __builtin_amdgcn_fence(__ATOMIC_ACQUIRE, "agent");
            xb_add(&bar[XB_XGEN(b.x)], 1u);
            asm volatile("s_waitcnt vmcnt(0)" ::: "memory");
        } else {
            XB_SPIN(xb_ld(&bar[XB_XGEN(b.x)]) == gen, bar);
            __builtin_amdgcn_fence(__ATOMIC_ACQUIRE, "agent");
            asm volatile("s_waitcnt vmcnt(0)" ::: "memory");
        }
    }
    __syncthreads();
}

struct Args { const float* in[16]; float* out; unsigned char* ws; int ph_lo, ph_hi; };
extern __shared__ __attribute__((aligned(16))) unsigned char lds_raw[];
constexpr int TAB_OFF = LDSCTL_OFF + 64;
#define LDSB ((LAS unsigned char*)lds_raw)
__device__ __forceinline__ GAS unsigned char* tab_ptr(int i) {
    volatile LAS unsigned* t = (volatile LAS unsigned*)(LDSB + TAB_OFF) + 2 * i;
    const unsigned lo = __builtin_amdgcn_readfirstlane(t[0]), hi = __builtin_amdgcn_readfirstlane(t[1]);
    return (GAS unsigned char*)(((unsigned long long)hi << 32) | lo);
}
#define TP(T, i) ((T*)tab_ptr(i))
#define TID ((int)threadIdx.x)
#define LANE ((int)(threadIdx.x & 63))
#define WAVE (__builtin_amdgcn_readfirstlane((int)(threadIdx.x >> 6)))
#define GRID ((int)gridDim.x)
#define BID ((int)blockIdx.x)
struct Frame {};
__device__ __forceinline__ int opaque_tid() { int t = threadIdx.x; asm volatile("" : "+v"(t)); return t; }
#define PHASE_IDS const int tid_o = opaque_tid(), lane_o = tid_o & 63, wave_o = __builtin_amdgcn_readfirstlane(tid_o >> 6)
__device__ __forceinline__ float wave_sum(float v) {
#pragma unroll
    for (int o = 1; o < 64; o <<= 1) v += __shfl_xor(v, o);
    return v;
}

__device__ __forceinline__ void transpose_item(const float* W, int ldw, int k0, int n0, bf16* WT, int ldd, int dst_row0, LAS float* scr, int lane) {
#pragma unroll 8
    for (int i = 0; i < 32; ++i) { const int kk = 2 * i + (lane >> 5); scr[kk * 33 + (lane & 31)] = W[(size_t)(k0 + kk) * ldw + n0 + (lane & 31)]; }
    LDS_WAIT(); asm volatile("" ::: "memory");
    const int c = lane & 7;
#pragma unroll
    for (int j = 0; j < 4; ++j) { const int n = (lane >> 3) + 8 * j; const LAS float* s = scr + (8 * c) * 33 + n;
        v4u o; o.x = pk2(s[0 * 33], s[1 * 33]); o.y = pk2(s[2 * 33], s[3 * 33]); o.z = pk2(s[4 * 33], s[5 * 33]); o.w = pk2(s[6 * 33], s[7 * 33]);
        *(GAS v4u*)(WT + (size_t)(dst_row0 + n) * ldd + k0 + 8 * c) = o; }
    LDS_WAIT(); asm volatile("" ::: "memory");
}
constexpr int IT_FI = (D / 64) * (FF2 / 32);
constexpr int IT_FO = (FF / 64) * (D / 32);
constexpr int IT_UQK = (D / 64) * (3072 / 32);
constexpr int IT_ALO = (D / 64);
constexpr int IT_V = (D / 64) * (2048 / 32);
constexpr int IT_RGG = (D / 64) * (6144 / 32);
constexpr int IT_POOL = 4 * (256 / 64) * (512 / 32);
constexpr int IT_SQ = (D / 64) * (D / 32);
constexpr int IT_LAYER = 2 * IT_FI + 2 * IT_FO + IT_UQK + IT_ALO + IT_V + IT_RGG + IT_POOL + 2 * IT_SQ;

__device__ __forceinline__ void p0_prologue(Frame& F) {
    PHASE_IDS;
    unsigned char* const ws = TP(unsigned char, 17);
    LAS float* scr = (LAS float*)(LDSB + wave_o * 16384);
    const int gw = BID * NWAVES + wave_o, NGW = GRID * NWAVES;
    const float* w_ffn_in = TP(const float, 6); const float* w_ffn_out = TP(const float, 7); const float* w_in = TP(const float, 8); const float* pool_w = TP(const float, 9);
    const float* w_gla_out = TP(const float, 14); const float* w_out = TP(const float, 15);
    for (int it = gw; it < 2 * IT_LAYER; it += NGW) {
        const int l = it / IT_LAYER; int r = it % IT_LAYER;
        if (r < 2 * IT_FI) { const int f = r / IT_FI; r %= IT_FI; const int nblk = FF2 / 32, kb = r / nblk, nb = r % nblk, n0 = 32 * nb, seg = n0 / FF, c = n0 % FF;
            transpose_item(w_ffn_in + (size_t)(l * 2 + f) * D * FF2, FF2, 64 * kb, n0, (bf16*)(ws + WS_WFI + (size_t)(l * 2 + f) * SZ_WFI), D, 256 * (c / 128) + 128 * seg + (c % 128), scr, lane_o); continue; }
        r -= 2 * IT_FI;
        if (r < 2 * IT_FO) { const int f = r / IT_FO; r %= IT_FO; const int nblk = D / 32, kb = r / nblk, nb = r % nblk;
            transpose_item(w_ffn_out + (size_t)(l * 2 + f) * FF * D, D, 64 * kb, 32 * nb, (bf16*)(ws + WS_WFO + (size_t)(l * 2 + f) * SZ_WFO), FF, 32 * nb, scr, lane_o); continue; }
        r -= 2 * IT_FO;
        const float* wi = w_in + (size_t)l * D * INW;
        if (r < IT_UQK) { const int nblk = 3072 / 32, kb = r / nblk, nb = r % nblk;
            transpose_item(wi, INW, 64 * kb, 32 * nb, (bf16*)(ws + WS_WUQKA + (size_t)l * SZ_WUQKA), D, 32 * nb, scr, lane_o); continue; }
        r -= IT_UQK;
        if (r < IT_ALO) { transpose_item(wi, INW, 64 * r, 5120, (bf16*)(ws + WS_WUQKA + (size_t)l * SZ_WUQKA), D, 3072, scr, lane_o); continue; }
        r -= IT_ALO;
        if (r < IT_V) { const int nblk = 2048 / 32, kb = r / nblk, nb = r % nblk;
            transpose_item(wi, INW, 64 * kb, 3072 + 32 * nb, (bf16*)(ws + WS_WV + (size_t)l * SZ_WV), D, 32 * nb, scr, lane_o); continue; }
        r -= IT_V;
        if (r < IT_RGG) { const int nblk = 6144 / 32, kb = r / nblk, nb = r % nblk;
            transpose_item(wi, INW, 64 * kb, 5136 + 32 * nb, (bf16*)(ws + WS_WRGG + (size_t)l * SZ_WRGG), D, 32 * nb, scr, lane_o); continue; }
        r -= IT_RGG;
        if (r < IT_POOL) { const int g = r / 64, rr = r % 64, kb = rr / 16, nb = rr % 16;
            transpose_item(pool_w + (size_t)(l * 4 + g) * 256 * 512, 512, 64 * kb, 32 * nb, (bf16*)(ws + WS_WPOOL + (size_t)l * SZ_WPOOL), 256, g * 512 + 32 * nb, scr, lane_o); continue; }
        r -= IT_POOL;
        if (r < IT_SQ) { const int nblk = D / 32, kb = r / nblk, nb = r % nblk;
            transpose_item(w_gla_out + (size_t)l * D * D, D, 64 * kb, 32 * nb, (bf16*)(ws + WS_WGO + (size_t)l * SZ_WSQ), D, 32 * nb, scr, lane_o); continue; }
        r -= IT_SQ;
        { const int nblk = D / 32, kb = r / nblk, nb = r % nblk;
            transpose_item(w_out + (size_t)l * D * D, D, 64 * kb, 32 * nb, (bf16*)(ws + WS_WO + (size_t)l * SZ_WSQ), D, 32 * nb, scr, lane_o); }
    }
    for (int l = 0; l < 2; ++l) { GAS v4u* z = (GAS v4u*)(ws + WS_WUQKA + (size_t)l * SZ_WUQKA + (size_t)3104 * D * 2); const int n16 = (3328 - 3104) * D * 2 / 16;
        for (int i = gw * 64 + lane_o; i < n16; i += NGW * 64) z[i] = (v4u){0u, 0u, 0u, 0u}; }
    const float* xp = TP(const float, 0); const float* xs = TP(const float, 1); bf16* XB = (bf16*)(ws + WS_XB);
    for (int m = gw; m < M; m += NGW) { const float* src = m < MP ? xp + (size_t)m * D : xs + (size_t)(m - MP) * D;
        const GAS f32x4* xr = (const GAS f32x4*)src + lane_o; GAS v2u* o8 = (GAS v2u*)(XB + (size_t)m * D) + lane_o;
#pragma unroll
        for (int j = 0; j < 8; ++j) { const f32x4 v = xr[64 * j]; o8[64 * j] = (v2u){pk2(v.x, v.y), pk2(v.z, v.w)}; } }
}

__device__ __forceinline__ void ln_phase(Frame& F, const float* Y, const float* g, const float* b, float* outF, bf16* outB) {
    PHASE_IDS;
    const int gw = BID * NWAVES + wave_o, NGW = GRID * NWAVES;
    for (int m = gw; m < M; m += NGW) {
        const GAS f32x4* xr = (const GAS f32x4*)(Y + (size_t)m * D) + lane_o;
        f32x4 v[8]; float s = 0.f;
#pragma unroll
        for (int j = 0; j < 8; ++j) { v[j] = xr[64 * j]; s += (v[j].x + v[j].y) + (v[j].z + v[j].w); }
        const float mean = wave_sum(s) * (1.f / D); float s2 = 0.f;
#pragma unroll
        for (int j = 0; j < 8; ++j) { v[j] = v[j] - mean; s2 += (v[j].x * v[j].x + v[j].y * v[j].y) + (v[j].z * v[j].z + v[j].w * v[j].w); }
        const float rstd = 1.f / sqrtf(wave_sum(s2) * (1.f / D) + LN_EPS);
        GAS f32x4* of = (GAS f32x4*)(outF + (size_t)m * D) + lane_o;
#pragma unroll
        for (int j = 0; j < 8; ++j) { const f32x4 gg = *((const f32x4*)g + lane_o + 64 * j), bb = *((const f32x4*)b + lane_o + 64 * j);
            v[j] = v[j] * rstd * gg + bb; of[64 * j] = v[j]; }
        if (outB) { GAS v2u* o8 = (GAS v2u*)(outB + (size_t)m * D) + lane_o;
#pragma unroll
            for (int j = 0; j < 8; ++j) o8[64 * j] = (v2u){pk2(v[j].x, v[j].y), pk2(v[j].z, v[j].w)}; }
    }
}

__device__ __forceinline__ void prepass_phase(Frame& F, int l) {
    PHASE_IDS;
    unsigned char* const ws = TP(unsigned char, 17); float* const outp = TP(float, 16);
    LAS float* tile = (LAS float*)(LDSB + wave_o * 16640);
    const int gw = BID * NWAVES + wave_o, NGW = GRID * NWAVES, lane = lane_o;
    const bf16* HQ = (const bf16*)(ws + WS_HQ); const float* ALO = (const float*)(ws + WS_ALO);
    bf16* QT = (bf16*)(ws + WS_QT); bf16* KT = (bf16*)(ws + WS_KT); bf16* KHT = (bf16*)(ws + WS_KHT); bf16* PO = (bf16*)(ws + WS_POOLED); float* GD = (float*)(ws + WS_GDEC);
    const float* state_pool = TP(const float, 2) + (size_t)l * DECB * PBUF * PW; const float* a_up = TP(const float, 11) + (size_t)l * RANK * GK; const float* a_bias = TP(const float, 12) + (size_t)l * GK;
    float* NPP = outp + O_NPP + (size_t)l * NB * PBUF * PW; float* NPS = outp + O_NPS + (size_t)l * DECB * PBUF * PW;
    for (int it = gw; it < 4096; it += NGW) {
        const bool samp = it >= 2048; const int r = it & 2047, cb = r & 15, cid = r >> 4;
        const int b = samp ? cid : (cid >> 5), ci = samp ? 0 : (cid & 31);
        const int t0 = samp ? MP + 8 * b : b * SEQ + 64 * ci, ntok = samp ? 8 : 64, pos0 = samp ? 0 : 64 * ci;
        const int c = 64 * cb + lane;
        float aup[16];
#pragma unroll
        for (int j = 0; j < 16; ++j) aup[j] = a_up[j * GK + c];
        const float ab = a_bias[c];
        float alo[16];
        { const int tr = lane < ntok ? lane : ntok - 1; const GAS f32x4* ap = (const GAS f32x4*)(ALO + (size_t)(t0 + tr) * 16);
#pragma unroll
          for (int j = 0; j < 4; ++j) { const f32x4 v = ap[j]; alo[4 * j] = v.x; alo[4 * j + 1] = v.y; alo[4 * j + 2] = v.z; alo[4 * j + 3] = v.w; } }
        const int w = 2 << (c >> 8);
        float wsum = 0.f;
        for (int j = 1; j < w; ++j) { const int p = pos0 - j;
            float e;
            if (p >= 0) e = bf2f(HQ[(size_t)(t0 - j) * 3072 + c]);
            else e = samp ? state_pool[((size_t)b * PBUF + (PBUF + p)) * PW + c] : 0.f;
            wsum += e; }
        if (samp) { for (int j = 0; j < 7; ++j) NPS[((size_t)b * PBUF + j) * PW + c] = state_pool[((size_t)b * PBUF + 8 + j) * PW + c]; }
        float bs = 0.f;
        for (int t = 0; t < ntok; ++t) {
            float z = ab;
#pragma unroll
            for (int j = 0; j < 16; ++j) z += __uint_as_float(__builtin_amdgcn_readlane(__float_as_uint(alo[j]), t)) * aup[j];
            const float la = -(fmaxf(-z, 0.f) + log1pf(__expf(-fabsf(z)))) * 0.0625f;
            bs += la;
            const size_t row = (size_t)(t0 + t);
            const float uq = bf2f(HQ[row * 3072 + c]), qv = bf2f(HQ[row * 3072 + 1024 + c]), kv = bf2f(HQ[row * 3072 + 2048 + c]);
            const float eb = __expf(bs), enb = __expf(-bs);
            QT[row * 1024 + c] = (bf16)f2bf(qv * eb);
            const float kt = kv * enb;
            KT[row * 1024 + c] = (bf16)f2bf(kt);
            tile[lane * 65 + t] = kt;
            wsum += uq;
            const int pos = pos0 + t; const float cnt = samp ? (float)w : (float)(pos + 1 < w ? pos + 1 : w);
            PO[row * 1024 + c] = (bf16)f2bf(wsum / cnt - uq);
            { const int p = pos - w + 1; float e;
              if (p >= 0) e = bf2f(HQ[(size_t)(t0 + t - w + 1) * 3072 + c]);
              else e = samp ? state_pool[((size_t)b * PBUF + (PBUF + p)) * PW + c] : 0.f;
              wsum -= e; }
            if (samp) NPS[((size_t)b * PBUF + 7 + t) * PW + c] = uq;
            else if (ci == 31 && t >= 49) NPP[((size_t)b * PBUF + (t - 49)) * PW + c] = uq;
        }
        const float gl = __expf(bs);
        GD[(size_t)((samp ? 128 : 0) + cid) * 1024 + c] = gl;
        LDS_WAIT(); asm volatile("" ::: "memory");
        const int tg = lane & 7;
#pragma unroll
        for (int i = 0; i < 8; ++i) { const int ch = 8 * i + (lane >> 3); const float gch = __shfl(gl, ch);
            if (8 * tg < ntok) { const LAS float* s = tile + ch * 65 + 8 * tg;
                v4u o; o.x = pk2(s[0] * gch, s[1] * gch); o.y = pk2(s[2] * gch, s[3] * gch); o.z = pk2(s[4] * gch, s[5] * gch); o.w = pk2(s[6] * gch, s[7] * gch);
                *(GAS v4u*)(KHT + (size_t)(64 * cb + ch) * M + t0 + 8 * tg) = o; } }
        LDS_WAIT(); asm volatile("" ::: "memory");
    }
}

constexpr int GL_QS = 0, GL_QS_STRIDE = 528, GL_KH = 64 * GL_QS_STRIDE, GL_KH_STRIDE = 144, GL_AL = GL_KH + 256 * GL_KH_STRIDE, GL_AL_STRIDE = 144, GL_END = GL_AL + 64 * GL_AL_STRIDE;
static_assert(GL_END <= RING_BYTES, "GLA LDS");
__device__ __forceinline__ void gla_prompt_unit(Frame& F, int l, int u) {
    PHASE_IDS;
    unsigned char* const ws = TP(unsigned char, 17); float* const outp = TP(float, 16);
    const int b = u >> 4, h = (u >> 2) & 3, vq = u & 3, w = wave_o, lane = lane_o, l15 = lane & 15, q = lane >> 4, tid = tid_o;
    const bf16* QT = (const bf16*)(ws + WS_QT); const bf16* KT = (const bf16*)(ws + WS_KT); const bf16* KHT = (const bf16*)(ws + WS_KHT); const bf16* VT = (const bf16*)(ws + WS_VT);
    const float* GD = (const float*)(ws + WS_GDEC); float* ORAW = (float*)(ws + WS_ORAW);
    const int vcol0 = h * 512 + vq * 128 + 16 * w;
    LAS unsigned char* lds = LDSB;
    f32x4 S[16];
#pragma unroll
    for (int i = 0; i < 16; ++i) S[i] = (f32x4){0.f, 0.f, 0.f, 0.f};
    for (int ci = 0; ci < 32; ++ci) {
        const int t0 = b * SEQ + 64 * ci;
        __syncthreads();
#pragma unroll
        for (int i = 0; i < 4; ++i) { const int p = tid + 512 * i, row = p >> 5, cs = p & 31;
            const v4u v = *(const GAS v4u*)(QT + (size_t)(t0 + row) * 1024 + h * 256 + cs * 8);
            *(LAS v4u*)(lds + GL_QS + row * GL_QS_STRIDE + cs * 16) = v; }
#pragma unroll
        for (int i = 0; i < 4; ++i) { const int p = tid + 512 * i, row = p >> 3, cs = p & 7;
            const v4u v = *(const GAS v4u*)(KHT + (size_t)(h * 256 + row) * M + t0 + cs * 8);
            *(LAS v4u*)(lds + GL_KH + row * GL_KH_STRIDE + cs * 16) = v; }
        bf16x8 vf[2];
#pragma unroll
        for (int s = 0; s < 2; ++s) vf[s] = *(const GAS bf16x8*)(VT + (size_t)(vcol0 + l15) * M + t0 + 32 * s + 8 * q);
        __syncthreads();
        {
            const int it = w >> 1;
#pragma unroll
            for (int jj = 0; jj < 2; ++jj) { const int jt = 2 * (w & 1) + jj;
                f32x4 acc = (f32x4){0.f, 0.f, 0.f, 0.f};
                if (jt <= it) {
#pragma unroll
                    for (int s = 0; s < 8; ++s) {
                        const bf16x8 af = *(const LAS bf16x8*)(lds + GL_QS + (16 * it + l15) * GL_QS_STRIDE + (32 * s + 8 * q) * 2);
                        const bf16x8 bfr = *(const GAS bf16x8*)(KT + (size_t)(t0 + 16 * jt + l15) * 1024 + h * 256 + 32 * s + 8 * q);
                        acc = __builtin_amdgcn_mfma_f32_16x16x32_bf16(af, bfr, acc, 0, 0, 0);
                    }
                }
#pragma unroll
                for (int r = 0; r < 4; ++r) { const int i = 16 * it + 4 * q + r, j = 16 * jt + l15; const float v = (j <= i) ? acc[r] : 0.f;
                    *(LAS bf16*)(lds + GL_AL + i * GL_AL_STRIDE + j * 2) = (bf16)f2bf(v); }
            }
        }
        __syncthreads();
        f32x4 oT[4];
#pragma unroll
        for (int it = 0; it < 4; ++it) oT[it] = (f32x4){0.f, 0.f, 0.f, 0.f};
#pragma unroll
        for (int s = 0; s < 8; ++s) {
            bf16x8 sf; { const f32x4 x0 = S[2 * s], x1 = S[2 * s + 1]; v4u wv; wv.x = pk2(x0[0], x0[1]); wv.y = pk2(x0[2], x0[3]); wv.z = pk2(x1[0], x1[1]); wv.w = pk2(x1[2], x1[3]); sf = __builtin_bit_cast(bf16x8, wv); }
#pragma unroll
            for (int it = 0; it < 4; ++it) {
                const LAS unsigned char* qp = lds + GL_QS + (16 * it + l15) * GL_QS_STRIDE + (32 * s + 4 * q) * 2;
                const v2u lo = *(const LAS v2u*)qp, hi = *(const LAS v2u*)(qp + 32);
                const bf16x8 qf = __builtin_bit_cast(bf16x8, (v4u){lo.x, lo.y, hi.x, hi.y});
                oT[it] = __builtin_amdgcn_mfma_f32_16x16x32_bf16(sf, qf, oT[it], 0, 0, 0);
            }
        }
#pragma unroll
        for (int s = 0; s < 2; ++s)
#pragma unroll
            for (int it = 0; it < 4; ++it) {
                const bf16x8 af = *(const LAS bf16x8*)(lds + GL_AL + (16 * it + l15) * GL_AL_STRIDE + (32 * s + 8 * q) * 2);
                oT[it] = __builtin_amdgcn_mfma_f32_16x16x32_bf16(vf[s], af, oT[it], 0, 0, 0);
            }
#pragma unroll
        for (int it = 0; it < 4; ++it) *(GAS f32x4*)(ORAW + (size_t)(t0 + 16 * it + l15) * 2048 + vcol0 + 4 * q) = oT[it];
        const float* gp = GD + (size_t)(b * 32 + ci) * 1024 + h * 256 + 4 * q;
#pragma unroll
        for (int kt = 0; kt < 16; ++kt) {
            const f32x4 gv = *(const GAS f32x4*)(gp + 16 * kt);
            f32x4 acc = S[kt] * gv;
#pragma unroll
            for (int s = 0; s < 2; ++s) {
                const bf16x8 kf = *(const LAS bf16x8*)(lds + GL_KH + (16 * kt + l15) * GL_KH_STRIDE + (32 * s + 8 * q) * 2);
                acc = __builtin_amdgcn_mfma_f32_16x16x32_bf16(kf, vf[s], acc, 0, 0, 0);
            }
            S[kt] = acc;
        }
    }
    float* NG = outp + O_NGP + ((size_t)((l * NB + b) * GH + h) * DK) * DV;
#pragma unroll
    for (int kt = 0; kt < 16; ++kt)
#pragma unroll
        for (int r = 0; r < 4; ++r) NG[(size_t)(16 * kt + 4 * q + r) * DV + vq * 128 + 16 * w + l15] = S[kt][r];
}

constexpr int GS_REC = 0, GS_REC_STRIDE = 20  , GS_A = 256 * GS_REC_STRIDE * 4, GS_KT = GS_A + 64 * 4, GS_RED = GS_KT + 8 * 257 * 4, GS_END = GS_RED + 4 * 8 * 512 * 4;
static_assert(GS_END <= RING_BYTES, "GLA sample LDS");
__device__ __forceinline__ void gla_sample_unit(Frame& F, int l, int u) {
    PHASE_IDS;
    unsigned char* const ws = TP(unsigned char, 17); float* const outp = TP(float, 16);
    const int b = u >> 2, h = u & 3, tid = tid_o;
    const bf16* QT = (const bf16*)(ws + WS_QT); const bf16* KT = (const bf16*)(ws + WS_KT); const bf16* KHT = (const bf16*)(ws + WS_KHT); const bf16* VT = (const bf16*)(ws + WS_VT);
    const float* GD = (const float*)(ws + WS_GDEC); float* ORAW = (float*)(ws + WS_ORAW);
    const float* S0 = TP(const float, 3) + ((size_t)((l * DECB + b) * GH + h) * DK) * DV; float* S1 = outp + O_NGS + ((size_t)((l * DECB + b) * GH + h) * DK) * DV;
    LAS float* rec = (LAS float*)(LDSB + GS_REC);
    LAS float* Am = (LAS float*)(LDSB + GS_A);
    LAS float* kts = (LAS float*)(LDSB + GS_KT);
    LAS float* red = (LAS float*)(LDSB + GS_RED);
    const int row0 = MP + 8 * b;
    __syncthreads();
    { const int i = tid >> 6, k4 = (tid & 63) * 4;
      const v2u qw = *(const GAS v2u*)(QT + (size_t)(row0 + i) * 1024 + h * 256 + k4); const v2u kw = *(const GAS v2u*)(KT + (size_t)(row0 + i) * 1024 + h * 256 + k4);
      rec[(k4 + 0) * GS_REC_STRIDE + i] = pg8::bf_lo(qw.x); rec[(k4 + 1) * GS_REC_STRIDE + i] = pg8::bf_hi(qw.x); rec[(k4 + 2) * GS_REC_STRIDE + i] = pg8::bf_lo(qw.y); rec[(k4 + 3) * GS_REC_STRIDE + i] = pg8::bf_hi(qw.y);
      kts[i * 257 + k4 + 0] = pg8::bf_lo(kw.x); kts[i * 257 + k4 + 1] = pg8::bf_hi(kw.x); kts[i * 257 + k4 + 2] = pg8::bf_lo(kw.y); kts[i * 257 + k4 + 3] = pg8::bf_hi(kw.y); }
    if (tid < 256) { const int k = tid; const v4u kh = *(const GAS v4u*)(KHT + (size_t)(h * 256 + k) * M + row0);
      LAS float* rp = rec + k * GS_REC_STRIDE + 8;
      rp[0] = pg8::bf_lo(kh.x); rp[1] = pg8::bf_hi(kh.x); rp[2] = pg8::bf_lo(kh.y); rp[3] = pg8::bf_hi(kh.y); rp[4] = pg8::bf_lo(kh.z); rp[5] = pg8::bf_hi(kh.z); rp[6] = pg8::bf_lo(kh.w); rp[7] = pg8::bf_hi(kh.w);
      rp[8] = GD[(size_t)(128 + b) * 1024 + h * 256 + k]; }
    __syncthreads();
    if (tid < 64) { const int i = tid >> 3, j = tid & 7; float s = 0.f;
      if (j <= i) for (int k = 0; k < 256; ++k) s += rec[k * GS_REC_STRIDE + i] * kts[j * 257 + k];
      Am[tid] = s; }
    const int c4 = tid & 127, kq = tid >> 7;
    float vv[8][4];
#pragma unroll
    for (int e = 0; e < 4; ++e) { const v4u t = *(const GAS v4u*)(VT + (size_t)(h * 512 + 4 * c4 + e) * M + row0);
        vv[0][e] = pg8::bf_lo(t.x); vv[1][e] = pg8::bf_hi(t.x); vv[2][e] = pg8::bf_lo(t.y); vv[3][e] = pg8::bf_hi(t.y); vv[4][e] = pg8::bf_lo(t.z); vv[5][e] = pg8::bf_hi(t.z); vv[6][e] = pg8::bf_lo(t.w); vv[7][e] = pg8::bf_hi(t.w); }
    f32x4 o[8];
#pragma unroll
    for (int i = 0; i < 8; ++i) o[i] = (f32x4){0.f, 0.f, 0.f, 0.f};
    const GAS f32x4* sp = (const GAS f32x4*)(S0 + (size_t)(64 * kq) * DV) + c4; GAS f32x4* dp = (GAS f32x4*)(S1 + (size_t)(64 * kq) * DV) + c4;
#pragma unroll 4
    for (int kk = 0; kk < 64; ++kk) {
        const f32x4 s0 = sp[(size_t)kk * (DV / 4)];
        const LAS f32x4* rp = (const LAS f32x4*)(rec + (64 * kq + kk) * GS_REC_STRIDE);
        const f32x4 q0 = rp[0], q1 = rp[1], k0 = rp[2], k1 = rp[3]; const float g = rec[(64 * kq + kk) * GS_REC_STRIDE + 16];
        f32x4 sn = s0 * g;
#pragma unroll
        for (int j = 0; j < 4; ++j) { const f32x4 v = (f32x4){vv[j][0], vv[j][1], vv[j][2], vv[j][3]}; sn += v * k0[j]; }
#pragma unroll
        for (int j = 0; j < 4; ++j) { const f32x4 v = (f32x4){vv[4 + j][0], vv[4 + j][1], vv[4 + j][2], vv[4 + j][3]}; sn += v * k1[j]; }
#pragma unroll
        for (int i = 0; i < 4; ++i) { o[i] += s0 * q0[i]; o[4 + i] += s0 * q1[i]; }
        dp[(size_t)kk * (DV / 4)] = sn;
    }
#pragma unroll
    for (int i = 0; i < 8; ++i) *(LAS f32x4*)(red + ((kq * 8 + i) * 512 + 4 * c4)) = o[i];
    __syncthreads();
#pragma unroll
    for (int rr = 0; rr < 2; ++rr) { const int idx = tid + 512 * rr, i = idx >> 7, cg = idx & 127;
        f32x4 acc = *(const LAS f32x4*)(red + ((0 * 8 + i) * 512 + 4 * cg)) + *(const LAS f32x4*)(red + ((1 * 8 + i) * 512 + 4 * cg)) + *(const LAS f32x4*)(red + ((2 * 8 + i) * 512 + 4 * cg)) + *(const LAS f32x4*)(red + ((3 * 8 + i) * 512 + 4 * cg));
        for (int j = 0; j <= i; ++j) { const float aij = Am[i * 8 + j];
            f32x4 vj;
#pragma unroll
            for (int e = 0; e < 4; ++e) vj[e] = bf2f(VT[(size_t)(h * 512 + 4 * cg + e) * M + row0 + j]);
            acc += vj * aij; }
        *(GAS f32x4*)(ORAW + (size_t)(row0 + i) * 2048 + h * 512 + 4 * cg) = acc; }
}

__device__ __forceinline__ void postnorm_phase(Frame& F, int l) {
    PHASE_IDS;
    unsigned char* const ws = TP(unsigned char, 17);
    const int gw = BID * NWAVES + wave_o, NGW = GRID * NWAVES, lane = lane_o;
    const float* ORAW = (const float*)(ws + WS_ORAW); const bf16* HR = (const bf16*)(ws + WS_HR); bf16* OG = (bf16*)(ws + WS_OG); const float* hg = TP(const float, 13) + (size_t)l * GV;
    for (int m = gw; m < M; m += NGW) {
        const GAS f32x4* orow = (const GAS f32x4*)(ORAW + (size_t)m * 2048);
        f32x4 v[8]; float rs[4];
#pragma unroll
        for (int hh = 0; hh < 4; ++hh) { v[2 * hh] = orow[hh * 128 + lane]; v[2 * hh + 1] = orow[hh * 128 + 64 + lane];
            float s = 0.f;
#pragma unroll
            for (int e = 0; e < 4; ++e) s += v[2 * hh][e] * v[2 * hh][e] + v[2 * hh + 1][e] * v[2 * hh + 1][e];
            rs[hh] = 1.f / sqrtf(wave_sum(s) * (1.f / 512.f) + HN_EPS); }
#pragma unroll
        for (int j = 0; j < 8; ++j) { const int col = (j >> 1) * 512 + (j & 1) * 256 + 4 * lane;
            const f32x4 g4 = *(const f32x4*)(hg + col); const v2u rw = *(const GAS v2u*)(HR + (size_t)m * 6144 + col);
            const f32x4 x = v[j] * rs[j >> 1] * g4;
            *(GAS v2u*)(OG + (size_t)m * 2048 + col) = (v2u){pk2(x[0] * pg8::bf_lo(rw.x), x[1] * pg8::bf_hi(rw.x)), pk2(x[2] * pg8::bf_lo(rw.y), x[3] * pg8::bf_hi(rw.y))}; }
    }
}

constexpr int N_PHASES = 27;
#define WSP(T, off) ((T*)(TP(unsigned char, 17) + (off)))
__global__ void __launch_bounds__(NWAVES * 64, 2) mega_fwd(Args args) {
    Frame F;
    for (int u = TID; u < (LDS_BYTES - LDSCTL_OFF) / 4; u += NWAVES * 64) ((LAS unsigned*)(LDSB + LDSCTL_OFF))[u] = 0u;
    __syncthreads();
    if (TID == 0) {
        LAS unsigned long long* tab = (LAS unsigned long long*)(LDSB + TAB_OFF);
#pragma unroll
        for (int i = 0; i < 16; ++i) tab[i] = (unsigned long long)args.in[i];
        tab[16] = (unsigned long long)args.out; tab[17] = (unsigned long long)args.ws;
    }
    const int lo = args.ph_lo, hi = args.ph_hi;
    __syncthreads();
    if (hi - lo > 1) (void)xcd_barrier_post(WSP(unsigned, WS_CTL) + CW_BAR, (volatile LAS unsigned*)(LDSB + MISC_OFF) + 8);
#define IN(k) (lo <= (k) && (k) < hi)
#define SEAM(k) do { if (IN(k) && IN((k) + 1)) { XcdBarrier bar_; bar_.bar = WSP(unsigned, WS_CTL) + CW_BAR; bar_.x = xb_xcc_id(); bar_.st = (volatile LAS unsigned*)(LDSB + MISC_OFF) + 8; xcd_barrier(bar_); } } while (0)
    int ph = 0;
#ifndef SKIP_P0
    if (IN(ph)) { p0_prologue(F); }
#endif
    SEAM(ph); ++ph;
#pragma unroll 1
    for (int l = 0; l < 2; ++l) {
#pragma unroll 1
        for (int f = 0; f < 2; ++f) {
            if (IN(ph)) {
#ifndef SKIP_FFI
                pg8::Gemm g{WSP(const bf16, WS_XB), WSP(const bf16, WS_WFI + (size_t)(l * 2 + f) * SZ_WFI), M, FF2, D, D, D, 31, 0};
                pg8::StaticOrder S; S.init(M, FF2, GRID, BID);
                pg8::EpiSwiGLU E{WSP(bf16, WS_ACT), FF};
                pg8::gemm_phase<pg8::EpiSwiGLU, pg8::StaticOrder>(LDSB, g, S, E);
#endif
            } SEAM(ph); ++ph;
            if (IN(ph)) {
#ifndef SKIP_FFO
                pg8::Gemm g{WSP(const bf16, WS_ACT), WSP(const bf16, WS_WFO + (size_t)(l * 2 + f) * SZ_WFO), M, D, FF, FF, FF, 31, 0};
                pg8::StaticOrder S; S.init(M, D, GRID, BID);
                const bool first = (l == 0 && f == 0);
                pg8::EpiResid E{WSP(float, WS_Y), first ? TP(const float, 0) : WSP(const float, WS_XF), first ? TP(const float, 1) : WSP(const float, WS_XF) + (size_t)MP * D, MP, ALPHA, 0.5f};
                pg8::gemm_phase<pg8::EpiResid, pg8::StaticOrder>(LDSB, g, S, E);
#endif
            } SEAM(ph); ++ph;
            if (IN(ph)) {
#ifndef SKIP_LN
                const int idx = (f == 0) ? 0 : 2; const bool fin = (l == 1 && f == 1);
                ln_phase(F, WSP(const float, WS_Y), TP(const float, 4) + (size_t)(l * 3 + idx) * D, TP(const float, 5) + (size_t)(l * 3 + idx) * D, fin ? TP(float, 16) + O_Y : WSP(float, WS_XF), fin ? nullptr : WSP(bf16, WS_XB));
#endif
            } SEAM(ph); ++ph;
            if (f == 0) {
                if (IN(ph)) {
#ifndef SKIP_UQKA
                    { pg8::Gemm g{WSP(const bf16, WS_XB), WSP(const bf16, WS_WUQKA + (size_t)l * SZ_WUQKA), M, 3328, D, D, D, 31, 0};
                      pg8::StaticOrder S; S.init(M, 3328, GRID, BID);
                      pg8::EpiUqka E{WSP(bf16, WS_HQ), WSP(float, WS_ALO)};
                      pg8::gemm_phase<pg8::EpiUqka, pg8::StaticOrder>(LDSB, g, S, E); }
#endif
#ifndef SKIP_RGG
                    { pg8::Gemm g{WSP(const bf16, WS_XB), WSP(const bf16, WS_WRGG + (size_t)l * SZ_WRGG), M, 6144, D, D, D, 31, 0};
                      pg8::StaticOrder S; S.init(M, 6144, GRID, (BID + GRID - 208) % GRID);
                      pg8::EpiRgg E{WSP(bf16, WS_HR)};
                      pg8::gemm_phase<pg8::EpiRgg, pg8::StaticOrder>(LDSB, g, S, E); }
#endif
#ifndef SKIP_VT
                    { pg8::Gemm g{WSP(const bf16, WS_WV + (size_t)l * SZ_WV), WSP(const bf16, WS_XB), D, M, D, D, D, 31, 0};
                      pg8::StaticOrder S; S.init(D, M, GRID, (BID + GRID - 48) % GRID);
                      pg8::EpiBf16 E{WSP(bf16, WS_VT), M};
                      pg8::gemm_phase<pg8::EpiBf16, pg8::StaticOrder>(LDSB, g, S, E); }
#endif
                } SEAM(ph); ++ph;
#ifndef SKIP_PRE
                if (IN(ph)) { prepass_phase(F, l); }
#endif
                SEAM(ph); ++ph;
                if (IN(ph)) {
#ifndef SKIP_GLAP
                    if (BID < 64) gla_prompt_unit(F, l, BID);
#endif
                    LAS unsigned* qslot = (LAS unsigned*)(LDSB + LDSCTL_OFF);
                    for (;;) {
                        __syncthreads();
                        if (TID == 0) qslot[0] = __hip_atomic_fetch_add(WSP(unsigned, WS_CTL) + CW_QUEUE + 64 * l, 1u, RLX_AGENT);
                        __syncthreads();
                        const unsigned u = ((volatile LAS unsigned*)qslot)[0];
                        if (u >= 512u) break;
#ifndef SKIP_GLAS
                        gla_sample_unit(F, l, (int)u);
#endif
                    }
                } SEAM(ph); ++ph;
                if (IN(ph)) {
#ifndef SKIP_POSTN
                    postnorm_phase(F, l);
#endif
                    __syncthreads();
#ifndef SKIP_POOL
                    int kpool = 256; asm volatile("" : "+s"(kpool));
                    pg8::Gemm g{WSP(const bf16, WS_POOLED), WSP(const bf16, WS_WPOOL + (size_t)l * SZ_WPOOL), M, D, kpool, 1024, 256, 1, 256};
                    pg8::StaticOrder S; S.init(M, D, GRID, BID);
                    pg8::EpiPool E{WSP(bf16, WS_YA), WSP(const bf16, WS_HR), TP(const float, 10) + (size_t)l * D};
                    pg8::gemm_phase<pg8::EpiPool, pg8::StaticOrder>(LDSB, g, S, E);
#endif
                } SEAM(ph); ++ph;
                if (IN(ph)) {
#ifndef SKIP_GO
                    pg8::Gemm g{WSP(const bf16, WS_OG), WSP(const bf16, WS_WGO + (size_t)l * SZ_WSQ), M, D, D, D, D, 31, 0};
                    pg8::StaticOrder S; S.init(M, D, GRID, BID);
                    pg8::EpiMerge E{WSP(bf16, WS_MG), WSP(const bf16, WS_YA), WSP(const bf16, WS_HR)};
                    pg8::gemm_phase<pg8::EpiMerge, pg8::StaticOrder>(LDSB, g, S, E);
#endif
                } SEAM(ph); ++ph;
                if (IN(ph)) {
#ifndef SKIP_WO
                    pg8::Gemm g{WSP(const bf16, WS_MG), WSP(const bf16, WS_WO + (size_t)l * SZ_WSQ), M, D, D, D, D, 31, 0};
                    pg8::StaticOrder S; S.init(M, D, GRID, BID);
                    pg8::EpiResid E{WSP(float, WS_Y), WSP(const float, WS_XF), WSP(const float, WS_XF) + (size_t)MP * D, MP, ALPHA, 1.0f};
                    pg8::gemm_phase<pg8::EpiResid, pg8::StaticOrder>(LDSB, g, S, E);
#endif
                } SEAM(ph); ++ph;
#ifndef SKIP_LN2
                if (IN(ph)) { ln_phase(F, WSP(const float, WS_Y), TP(const float, 4) + (size_t)(l * 3 + 1) * D, TP(const float, 5) + (size_t)(l * 3 + 1) * D, WSP(float, WS_XF), WSP(bf16, WS_XB)); }
#endif
                SEAM(ph); ++ph;
            }
        }
    }
#undef IN
#undef SEAM
}

extern "C" void kernel_launch(void* const* d_in, const int* in_sizes, int n_in, void* d_out, int out_size, void* d_ws, size_t ws_size, hipStream_t stream) {
    static int grid = 0;
    if (grid == 0) {
        if (n_in != 16 || (size_t)out_size != O_END || ws_size < WS_END) { fprintf(stderr, "kernel_launch: unexpected shapes (n_in %d out %d ws %zu need %zu)\n", n_in, out_size, ws_size, (size_t)WS_END); grid = -1; return; }
        int dev = 0, cus = 0, per_cu = 0;
        if (hipGetDevice(&dev) != hipSuccess || hipDeviceGetAttribute(&cus, hipDeviceAttributeMultiprocessorCount, dev) != hipSuccess) { grid = -1; return; }
        if (hipFuncSetAttribute((const void*)mega_fwd, hipFuncAttributeMaxDynamicSharedMemorySize, LDS_BYTES) != hipSuccess) { fprintf(stderr, "kernel_launch: hipFuncSetAttribute failed\n"); grid = -1; return; }
        if (hipOccupancyMaxActiveBlocksPerMultiprocessor(&per_cu, (const void*)mega_fwd, NWAVES * 64, LDS_BYTES) != hipSuccess || per_cu < 1)
            fprintf(stderr, "kernel_launch: occupancy query reports %d workgroups per CU\n", per_cu);
        (void)hipGetLastError();
        grid = cus;
    }
    if (grid < 0) return;
    if (hipMemsetAsync((char*)d_ws + WS_CTL, 0, CTL_ZERO_BYTES, stream) != hipSuccess) return;
    Args a{};
    for (int i = 0; i < 16; ++i) a.in[i] = (const float*)d_in[i];
    a.out = (float*)d_out; a.ws = (unsigned char*)d_ws;
#if MK_PER_PHASE
    for (int p = 0; p < N_PHASES; ++p) { a.ph_lo = p; a.ph_hi = p + 1; hipLaunchKernelGGL(mega_fwd, dim3(grid), dim3(NWAVES * 64), LDS_BYTES, stream, a); }
#else
    a.ph_lo = 0; a.ph_hi = N_PHASES;
    hipLaunchKernelGGL(mega_fwd, dim3(grid), dim3(NWAVES * 64), LDS_BYTES, stream, a);
#endif
}
```

```cpp
#include <hip/hip_runtime.h>
#include <cstdio>
#include <cstdint>

#ifndef MK_PER_PHASE
#define MK_PER_PHASE 0
#endif

namespace pg8 {
#define PG8_LAS __attribute__((address_space(3)))
typedef unsigned short bf16_t;
typedef short bf16x8 __attribute__((ext_vector_type(8)));
typedef float f32x4 __attribute__((ext_vector_type(4)));
typedef unsigned u32x4 __attribute__((ext_vector_type(4)));
typedef unsigned u32x2 __attribute__((ext_vector_type(2)));
constexpr int BM = 256, BK = 64, HALF = 128, HTB = HALF * BK * 2  , STAGE_BYTES = 8 * HTB, NXCD = 8, WGM = 8;

__host__ __device__ __forceinline__ int lds_byte(int r, int c) { const int st = (r >> 4) * 2 + (c >> 5), rr = r & 15, cc = c & 31, ob = rr * 64 + cc * 2; return st * 1024 + (ob ^ (((ob >> 9) & 1) << 5)); }
__host__ __device__ __forceinline__ void stage_rc(int b, int& R, int& C) { const int st = b / 1024, sb = b % 1024, swz = sb ^ (((sb >> 9) & 1) << 5); R = (st >> 1) * 16 + swz / 64; C = (st & 1) * 32 + (swz % 64) / 2; }
__host__ __device__ __forceinline__ int perm32(int rho) { const int n = rho >> 4, i = rho & 15; return 8 * (i >> 2) + 4 * n + (i & 3); }

struct Unit { int pm, pn; };
struct Gemm { const bf16_t* A; const bf16_t* Bt; int M, N, K, lda, ldb, a_shift, a_mul; };

struct StaticOrder {
    int nM, nN, nwg, G, c;
    __host__ __device__ void init(int M, int N, int G_, int c_) { nM = M / BM; nN = N / BM; nwg = nM * nN; G = G_; c = c_; }
    __host__ __device__ bool next(int i, Unit& u) const {
        const long L = (long)i * G + c; if (L >= nwg) return false;
        int wgid = (int)L; { const int q = nwg / NXCD, r = nwg % NXCD, xcd = wgid % NXCD, off = wgid / NXCD; wgid = (xcd < r ? xcd * (q + 1) : r * (q + 1) + (xcd - r) * q) + off; }
        const int nig = WGM * nN, gid = wgid / nig, fm = gid * WGM, gsz = (nM - fm) < WGM ? (nM - fm) : WGM;
        u.pm = fm + ((wgid % nig) % gsz); u.pn = (wgid % nig) / gsz; return true;
    }
    __device__ __forceinline__ void a_ready(const Unit&) const {}
    __device__ __forceinline__ void done(const Unit&) const {}
};

__device__ __forceinline__ unsigned cvt_pk_bf16(float lo, float hi) { unsigned r; asm volatile("v_cvt_pk_bf16_f32 %0, %1, %2" : "=v"(r) : "v"(lo), "v"(hi)); return r; }
__device__ __forceinline__ float bf_lo(unsigned w) { return __uint_as_float(w << 16); }
__device__ __forceinline__ float bf_hi(unsigned w) { return __uint_as_float(w & 0xffff0000u); }
__device__ __forceinline__ float sigmoidf_(float x) { return __builtin_amdgcn_rcpf(1.0f + __expf(-x)); }
__device__ __forceinline__ float siluf_(float x) { return x * sigmoidf_(x); }


struct EpiBf16 {
    static constexpr bool PERM = true;
    bf16_t* O; int ldc;
    __device__ __forceinline__ void operator()(const f32x4 (&acc)[2][2][4][2], const Unit& u, int wr, int wc, int fr, int fq) const {
        const int row0 = u.pm * BM + wr * 64 + fr, col0 = u.pn * BM + wc * 32 + 8 * fq;
#pragma unroll
        for (int ai = 0; ai < 2; ++ai)
#pragma unroll
            for (int m = 0; m < 4; ++m) { bf16_t* rowp = O + (size_t)(row0 + ai * HALF + m * 16) * ldc + col0;
#pragma unroll
                for (int bj = 0; bj < 2; ++bj) { const f32x4 v0 = acc[ai][bj][m][0], v1 = acc[ai][bj][m][1];
                    u32x4 w; w.x = cvt_pk_bf16(v0[0], v0[1]); w.y = cvt_pk_bf16(v0[2], v0[3]); w.z = cvt_pk_bf16(v1[0], v1[1]); w.w = cvt_pk_bf16(v1[2], v1[3]);
                    *(u32x4*)(rowp + bj * HALF) = w; } }
    }
};
struct EpiSwiGLU {
    static constexpr bool PERM = true;
    bf16_t* O; int ldc;
    __device__ __forceinline__ void operator()(const f32x4 (&acc)[2][2][4][2], const Unit& u, int wr, int wc, int fr, int fq) const {
        const int row0 = u.pm * BM + wr * 64 + fr, col0 = u.pn * HALF + wc * 32 + 8 * fq;
#pragma unroll
        for (int ai = 0; ai < 2; ++ai)
#pragma unroll
            for (int m = 0; m < 4; ++m) { bf16_t* rowp = O + (size_t)(row0 + ai * HALF + m * 16) * ldc + col0;
                float o[8];
#pragma unroll
                for (int n = 0; n < 2; ++n)
#pragma unroll
                    for (int e = 0; e < 4; ++e) o[4 * n + e] = siluf_(acc[ai][0][m][n][e]) * acc[ai][1][m][n][e];
                u32x4 w; w.x = cvt_pk_bf16(o[0], o[1]); w.y = cvt_pk_bf16(o[2], o[3]); w.z = cvt_pk_bf16(o[4], o[5]); w.w = cvt_pk_bf16(o[6], o[7]);
                *(u32x4*)rowp = w; }
    }
};
struct EpiResid {
    static constexpr bool PERM = false;
    float* Y; const float* resA; const float* resB; int split; float alpha, s;
    __device__ __forceinline__ void operator()(const f32x4 (&acc)[2][2][4][2], const Unit& u, int wr, int wc, int fr, int fq) const {
        const int row0 = u.pm * BM + wr * 64 + fr, col0 = u.pn * BM + wc * 32 + 4 * fq;
        const float* rbase = (u.pm * BM < split) ? resA + (size_t)row0 * 2048 : resB + (size_t)(row0 - split) * 2048;
#pragma unroll
        for (int ai = 0; ai < 2; ++ai)
#pragma unroll
            for (int m = 0; m < 4; ++m) { const size_t ro = (size_t)(ai * HALF + m * 16) * 2048 + col0; float* yp = Y + (size_t)row0 * 2048 + ro; const float* rp = rbase + ro;
#pragma unroll
                for (int bj = 0; bj < 2; ++bj)
#pragma unroll
                    for (int n = 0; n < 2; ++n) { const f32x4 r = *(const f32x4*)(rp + bj * HALF + n * 16); *(f32x4*)(yp + bj * HALF + n * 16) = r * alpha + acc[ai][bj][m][n] * s; }
                asm volatile("" ::: "memory"); }
    }
};
struct EpiUqka {
    static constexpr bool PERM = true;
    bf16_t* HQ; float* ALO;
    __device__ __forceinline__ void operator()(const f32x4 (&acc)[2][2][4][2], const Unit& u, int wr, int wc, int fr, int fq) const {
        const int row0 = u.pm * BM + wr * 64 + fr;
        if (u.pn < 12) {
            const float sc = (u.pn >= 4 && u.pn < 8) ? 0.0625f : 1.0f; const int col0 = u.pn * BM + wc * 32 + 8 * fq;
#pragma unroll
            for (int ai = 0; ai < 2; ++ai)
#pragma unroll
                for (int m = 0; m < 4; ++m) { bf16_t* rowp = HQ + (size_t)(row0 + ai * HALF + m * 16) * 3072 + col0;
#pragma unroll
                    for (int bj = 0; bj < 2; ++bj) { const f32x4 v0 = acc[ai][bj][m][0] * sc, v1 = acc[ai][bj][m][1] * sc;
                        u32x4 w; w.x = cvt_pk_bf16(v0[0], v0[1]); w.y = cvt_pk_bf16(v0[2], v0[3]); w.z = cvt_pk_bf16(v1[0], v1[1]); w.w = cvt_pk_bf16(v1[2], v1[3]);
                        *(u32x4*)(rowp + bj * HALF) = w; } }
        } else if (wc == 0 && fq < 2) {
#pragma unroll
            for (int ai = 0; ai < 2; ++ai)
#pragma unroll
                for (int m = 0; m < 4; ++m) { float* rowp = ALO + (size_t)(row0 + ai * HALF + m * 16) * 16 + 8 * fq;
                    *(f32x4*)rowp = acc[ai][0][m][0]; *(f32x4*)(rowp + 4) = acc[ai][0][m][1]; }
        }
    }
};
struct EpiRgg {
    static constexpr bool PERM = true;
    bf16_t* HR;
    __device__ __forceinline__ void operator()(const f32x4 (&acc)[2][2][4][2], const Unit& u, int wr, int wc, int fr, int fq) const {
        const int row0 = u.pm * BM + wr * 64 + fr, col0 = u.pn * BM + wc * 32 + 8 * fq; const bool is_r = u.pn < 8;
#pragma unroll
        for (int ai = 0; ai < 2; ++ai)
#pragma unroll
            for (int m = 0; m < 4; ++m) { bf16_t* rowp = HR + (size_t)(row0 + ai * HALF + m * 16) * 6144 + col0;
#pragma unroll
                for (int bj = 0; bj < 2; ++bj) { float o[8];
#pragma unroll
                    for (int n = 0; n < 2; ++n)
#pragma unroll
                        for (int e = 0; e < 4; ++e) { const float x = acc[ai][bj][m][n][e], sg = sigmoidf_(x); o[4 * n + e] = is_r ? x * sg : sg; }
                    u32x4 w; w.x = cvt_pk_bf16(o[0], o[1]); w.y = cvt_pk_bf16(o[2], o[3]); w.z = cvt_pk_bf16(o[4], o[5]); w.w = cvt_pk_bf16(o[6], o[7]);
                    *(u32x4*)(rowp + bj * HALF) = w; } }
    }
};
struct EpiPool {
    static constexpr bool PERM = true;
    bf16_t* YA; const bf16_t* HR; const float* ps;
    __device__ __forceinline__ void operator()(const f32x4 (&acc)[2][2][4][2], const Unit& u, int wr, int wc, int fr, int fq) const {
        const int row0 = u.pm * BM + wr * 64 + fr, col0 = u.pn * BM + wc * 32 + 8 * fq;
#pragma unroll
        for (int bj = 0; bj < 2; ++bj) { const f32x4 pv0 = *(const f32x4*)(ps + col0 + bj * HALF), pv1 = *(const f32x4*)(ps + col0 + bj * HALF + 4);
#pragma unroll
        for (int ai = 0; ai < 2; ++ai)
#pragma unroll
            for (int m = 0; m < 4; ++m) { const size_t r = (size_t)(row0 + ai * HALF + m * 16);
                { const u32x4 g = *(const u32x4*)(HR + r * 6144 + 2048 + col0 + bj * HALF);
                    const f32x4 v0 = acc[ai][bj][m][0] * pv0, v1 = acc[ai][bj][m][1] * pv1;
                    u32x4 w; w.x = cvt_pk_bf16(v0[0] * bf_lo(g.x), v0[1] * bf_hi(g.x)); w.y = cvt_pk_bf16(v0[2] * bf_lo(g.y), v0[3] * bf_hi(g.y));
                    w.z = cvt_pk_bf16(v1[0] * bf_lo(g.z), v1[1] * bf_hi(g.z)); w.w = cvt_pk_bf16(v1[2] * bf_lo(g.w), v1[3] * bf_hi(g.w));
                    *(u32x4*)(YA + r * 2048 + col0 + bj * HALF) = w; }
                if (m & 1) asm volatile("" ::: "memory"); } }
    }
};
struct EpiMerge {
    static constexpr bool PERM = true;
    bf16_t* MG; const bf16_t* YA; const bf16_t* HR;
    __device__ __forceinline__ void operator()(const f32x4 (&acc)[2][2][4][2], const Unit& u, int wr, int wc, int fr, int fq) const {
        const int row0 = u.pm * BM + wr * 64 + fr, col0 = u.pn * BM + wc * 32 + 8 * fq;
#pragma unroll
        for (int ai = 0; ai < 2; ++ai)
#pragma unroll
            for (int m = 0; m < 4; ++m) { const size_t r = (size_t)(row0 + ai * HALF + m * 16);
#pragma unroll
                for (int bj = 0; bj < 2; ++bj) { const u32x4 g = *(const u32x4*)(HR + r * 6144 + 4096 + col0 + bj * HALF); const u32x4 y = *(const u32x4*)(YA + r * 2048 + col0 + bj * HALF);
                    const f32x4 v0 = acc[ai][bj][m][0], v1 = acc[ai][bj][m][1];
                    u32x4 w; w.x = cvt_pk_bf16(bf_lo(y.x) + v0[0] * bf_lo(g.x), bf_hi(y.x) + v0[1] * bf_hi(g.x)); w.y = cvt_pk_bf16(bf_lo(y.y) + v0[2] * bf_lo(g.y), bf_hi(y.y) + v0[3] * bf_hi(g.y));
                    w.z = cvt_pk_bf16(bf_lo(y.z) + v1[0] * bf_lo(g.z), bf_hi(y.z) + v1[1] * bf_hi(g.z)); w.w = cvt_pk_bf16(bf_lo(y.w) + v1[2] * bf_lo(g.w), bf_hi(y.w) + v1[3] * bf_hi(g.w));
                    *(u32x4*)(MG + r * 2048 + col0 + bj * HALF) = w; }
                asm volatile("" ::: "memory"); }
    }
};

template <class Epi, class Sched, bool ALIGN_EPI = true, bool SP2 = true>
__device__ __forceinline__ void gemm_phase(PG8_LAS unsigned char* lds, const Gemm g, const Sched& S, const Epi& E) {
    int tid_ = threadIdx.x; asm volatile("" : "+v"(tid_));
    const int tid = tid_, wid = __builtin_amdgcn_readfirstlane(tid >> 6), lane = tid & 63, wr = wid >> 2, wc = wid & 3, fr = lane & 15, fq = lane >> 4;
    const int K = g.K, nt = K / BK;
    unsigned voffA[2], voffB[2];
#pragma unroll
    for (int i = 0; i < 2; ++i) { int R, C; stage_rc(tid * 16 + i * 8192, R, C); const int Rb = Epi::PERM ? ((R & ~31) + perm32(R & 31)) : R;
        voffA[i] = (unsigned)(R * g.lda + C) * 2u; voffB[i] = (unsigned)(Rb * g.ldb + C) * 2u; }
    const size_t kstep = (size_t)(BK * 2);
    const size_t hstepA = (size_t)HALF * g.lda * 2, hstepB = (size_t)HALF * g.ldb * 2;
    const size_t tstepA = 2 * hstepA, tstepB = 2 * hstepB;
    const unsigned ldsw = (unsigned)wid * 1024u;
    const int aoff = lds_byte(wr * 64 + fr, fq * 8), boff = lds_byte(wc * 32 + fr, fq * 8);
#define PG8_SA(b, h) (((b) * 2 + (h)) * HTB)
#define PG8_SB(b, h) ((4 + (b) * 2 + (h)) * HTB)
#define PG8_STAGE(bufoff, gbase, voff) do { _Pragma("unroll") for (int _i = 0; _i < 2; ++_i) \
        __builtin_amdgcn_global_load_lds((const unsigned*)((const char*)(gbase) + (voff)[_i]), (PG8_LAS unsigned*)(lds + (bufoff) + ldsw + _i * 8192), 16, 0, 0); } while (0)
#define PG8_LDA(dst, b, h) do { _Pragma("unroll") for (int m = 0; m < 4; ++m) _Pragma("unroll") for (int k = 0; k < 2; ++k) dst[m][k] = *(const PG8_LAS bf16x8*)(lds + PG8_SA(b, h) + aoff + m * 2048 + k * 1024); } while (0)
#define PG8_LDB(dst, b, h) do { _Pragma("unroll") for (int n = 0; n < 2; ++n) _Pragma("unroll") for (int k = 0; k < 2; ++k) dst[n][k] = *(const PG8_LAS bf16x8*)(lds + PG8_SB(b, h) + boff + n * 2048 + k * 1024); } while (0)
#define PG8_MMA(ai, bj, At, Bt) do { __builtin_amdgcn_s_setprio(1); _Pragma("unroll") for (int m = 0; m < 4; ++m) _Pragma("unroll") for (int n = 0; n < 2; ++n) _Pragma("unroll") for (int k = 0; k < 2; ++k) \
        acc[ai][bj][m][n] = __builtin_amdgcn_mfma_f32_16x16x32_bf16(Bt[n][k], At[m][k], acc[ai][bj][m][n], 0, 0, 0); __builtin_amdgcn_s_setprio(0); } while (0)
#define PG8_WAIT_V(n) asm volatile("s_waitcnt vmcnt(" #n ")" ::: "memory")
#define PG8_WAIT_L(n) asm volatile("s_waitcnt lgkmcnt(" #n ")" ::: "memory")
#define PG8_BAR __builtin_amdgcn_s_barrier()
#define PG8_SCHED __builtin_amdgcn_sched_barrier(0)
#define PG8_APTR(u) ((const char*)g.A + (size_t)(u).pm * tstepA + (size_t)(((u).pn >> g.a_shift) * g.a_mul) * 2)
#define PG8_BPTR(u) ((const char*)g.Bt + (size_t)(u).pn * tstepB)
    Unit cur, nxt; int ui = 0;
    if (!S.next(0, cur)) return;
    f32x4 acc[2][2][4][2];
#pragma unroll
    for (int a = 0; a < 2; ++a)
#pragma unroll
        for (int b = 0; b < 2; ++b)
#pragma unroll
            for (int m = 0; m < 4; ++m)
#pragma unroll
                for (int n = 0; n < 2; ++n) acc[a][b][m][n] = (f32x4){0.f, 0.f, 0.f, 0.f};
    bf16x8 At[4][2], B0[2][2], B1[2][2];
    const char* cA = PG8_APTR(cur); const char* cB = PG8_BPTR(cur);
    S.a_ready(cur);
    if constexpr (SP2) {
        PG8_STAGE(PG8_SB(0, 0), cB, voffB); PG8_STAGE(PG8_SB(0, 1), cB + hstepB, voffB); PG8_STAGE(PG8_SA(0, 0), cA, voffA); PG8_STAGE(PG8_SA(0, 1), cA + hstepA, voffA);
        if (wr == 1) PG8_BAR;
        PG8_WAIT_V(2); PG8_BAR;
        PG8_STAGE(PG8_SB(1, 0), cB + kstep, voffB); PG8_STAGE(PG8_SA(1, 0), cA + kstep, voffA); PG8_STAGE(PG8_SB(1, 1), cB + hstepB + kstep, voffB);
        PG8_WAIT_V(6); PG8_BAR;
    } else {
        PG8_STAGE(PG8_SB(0, 0), cB, voffB); PG8_STAGE(PG8_SA(0, 0), cA, voffA); PG8_STAGE(PG8_SB(0, 1), cB + hstepB, voffB); PG8_STAGE(PG8_SA(0, 1), cA + hstepA, voffA);
        if (wr == 1) PG8_BAR;
        PG8_WAIT_V(4); PG8_BAR;
        PG8_STAGE(PG8_SB(1, 0), cB + kstep, voffB); PG8_STAGE(PG8_SA(1, 0), cA + kstep, voffA); PG8_STAGE(PG8_SB(1, 1), cB + hstepB + kstep, voffB);
        PG8_WAIT_V(6); PG8_BAR;
    }
    for (;;) {
        const bool has_next = S.next(ui + 1, nxt);
        const char* nA = has_next ? PG8_APTR(nxt) : cA; const char* nB = has_next ? PG8_BPTR(nxt) : cB;
        for (int t = 0; t < nt; t += 2) {
            const bool last = (t == nt - 2);
            const char* a1 = cA + (size_t)(t + 1) * kstep;
            const char* a2 = last ? nA : cA + (size_t)(t + 2) * kstep; const char* b2 = last ? nB : cB + (size_t)(t + 2) * kstep;
            const char* a3 = a2 + kstep; const char* b3 = b2 + kstep;
            if (last && has_next) S.a_ready(nxt);
            if constexpr (SP2) {
            PG8_LDB(B0, 0, 0); PG8_LDB(B1, 0, 1); PG8_SCHED; PG8_LDA(At, 0, 0); PG8_STAGE(PG8_SA(1, 1), a1 + hstepA, voffA);
            PG8_WAIT_V(8); PG8_WAIT_L(0); PG8_BAR; PG8_MMA(0, 0, At, B0); PG8_MMA(0, 1, At, B1); PG8_BAR; PG8_SCHED;
            PG8_LDA(At, 0, 1); PG8_STAGE(PG8_SB(0, 0), b2, voffB); PG8_STAGE(PG8_SB(0, 1), b2 + hstepB, voffB); PG8_STAGE(PG8_SA(0, 0), a2, voffA);
            PG8_WAIT_V(8); PG8_WAIT_L(0); PG8_BAR; PG8_MMA(1, 0, At, B0); PG8_MMA(1, 1, At, B1); PG8_BAR; PG8_SCHED;
            PG8_LDB(B0, 1, 0); PG8_LDB(B1, 1, 1); PG8_SCHED; PG8_LDA(At, 1, 0); PG8_STAGE(PG8_SA(0, 1), a2 + hstepA, voffA);
            PG8_WAIT_V(8); PG8_WAIT_L(0); PG8_BAR; PG8_MMA(0, 0, At, B0); PG8_MMA(0, 1, At, B1); PG8_BAR; PG8_SCHED;
            PG8_LDA(At, 1, 1); PG8_STAGE(PG8_SB(1, 0), b3, voffB); PG8_STAGE(PG8_SB(1, 1), b3 + hstepB, voffB); PG8_STAGE(PG8_SA(1, 0), a3, voffA);
            PG8_WAIT_V(8); PG8_WAIT_L(0); PG8_BAR; PG8_MMA(1, 0, At, B0); PG8_MMA(1, 1, At, B1); PG8_BAR; PG8_SCHED;
            } else {
            PG8_LDB(B0, 0, 0); PG8_SCHED; PG8_LDA(At, 0, 0); PG8_STAGE(PG8_SA(1, 1), a1 + hstepA, voffA);
            PG8_WAIT_L(8); PG8_BAR; PG8_WAIT_L(0); PG8_MMA(0, 0, At, B0); PG8_BAR; PG8_SCHED;
            PG8_LDB(B1, 0, 1); PG8_STAGE(PG8_SB(0, 0), b2, voffB);
            PG8_BAR; PG8_WAIT_L(0); PG8_MMA(0, 1, At, B1); PG8_BAR;
            PG8_LDA(At, 0, 1); PG8_STAGE(PG8_SA(0, 0), a2, voffA);
            PG8_BAR; PG8_WAIT_L(0); PG8_MMA(1, 0, At, B0); PG8_BAR; PG8_SCHED;
            PG8_STAGE(PG8_SB(0, 1), b2 + hstepB, voffB);
            PG8_WAIT_V(6); PG8_BAR; PG8_MMA(1, 1, At, B1); PG8_BAR;
            PG8_LDB(B0, 1, 0); PG8_SCHED; PG8_LDA(At, 1, 0); PG8_STAGE(PG8_SA(0, 1), a2 + hstepA, voffA);
            PG8_WAIT_L(8); PG8_BAR; PG8_WAIT_L(0); PG8_MMA(0, 0, At, B0); PG8_BAR; PG8_SCHED;
            PG8_LDB(B1, 1, 1); PG8_STAGE(PG8_SB(1, 0), b3, voffB);
            PG8_BAR; PG8_WAIT_L(0); PG8_MMA(0, 1, At, B1); PG8_BAR;
            PG8_LDA(At, 1, 1); PG8_STAGE(PG8_SA(1, 0), a3, voffA);
            PG8_BAR; PG8_WAIT_L(0); PG8_MMA(1, 0, At, B0); PG8_BAR; PG8_SCHED;
            PG8_STAGE(PG8_SB(1, 1), b3 + hstepB, voffB);
            PG8_WAIT_V(6); PG8_BAR; PG8_MMA(1, 1, At, B1); PG8_BAR;
            }
        }
        if constexpr (ALIGN_EPI) { if (wr == 0) PG8_BAR; }
        E(acc, cur, wr, wc, fr, fq); S.done(cur);
        if (!has_next) break;
#pragma unroll
        for (int a = 0; a < 2; ++a)
#pragma unroll
            for (int b = 0; b < 2; ++b)
#pragma unroll
                for (int m = 0; m < 4; ++m)
#pragma unroll
                    for (int n = 0; n < 2; ++n) acc[a][b][m][n] = (f32x4){0.f, 0.f, 0.f, 0.f};
        cur = nxt; cA = nA; cB = nB; ++ui;
        if constexpr (ALIGN_EPI) { if (wr == 1) PG8_BAR; }
    }
    PG8_WAIT_V(0);
    if constexpr (!ALIGN_EPI) { if (wr == 0) PG8_BAR; }
    PG8_BAR;
#undef PG8_SA
#undef PG8_SB
#undef PG8_STAGE
#undef PG8_LDA
#undef PG8_LDB
#undef PG8_MMA
#undef PG8_WAIT_V
#undef PG8_WAIT_L
#undef PG8_BAR
#undef PG8_SCHED
#undef PG8_APTR
#undef PG8_BPTR
}
}

constexpr int NWAVES = 8;
constexpr int D = 2048, MP = 8192, MS = 1024, M = MP + MS;
constexpr int SEQ = 2048, NB = 4, DECB = 128, DECT = 8;
constexpr int FF = 5632, FF2 = 2 * FF, INW = 11280;
constexpr int PW = 1024, PBUF = 15;
constexpr int GH = 4, DK = 256, DV = 512, GK = 1024, GV = 2048, RANK = 16;
constexpr float LN_EPS = 1e-5f, HN_EPS = 1e-6f;
constexpr float ALPHA = 1.41421356237309515f;
constexpr int NCHUNK = 256;

constexpr size_t O_Y = 0, O_NPP = (size_t)M * D, O_NGP = O_NPP + (size_t)2 * NB * PBUF * PW, O_NPS = O_NGP + (size_t)2 * NB * GH * DK * DV,
                 O_NGS = O_NPS + (size_t)2 * DECB * PBUF * PW, O_END = O_NGS + (size_t)2 * DECB * GH * DK * DV;

constexpr size_t MiB = 1u << 20;
constexpr size_t WS_CTL = 0, CTL_ZERO_BYTES = 1 * MiB;
constexpr size_t SZ_WFI = (size_t)FF2 * D * 2, SZ_WFO = (size_t)D * FF * 2, SZ_WUQKA = (size_t)3328 * D * 2, SZ_WV = (size_t)D * D * 2, SZ_WRGG = (size_t)6144 * D * 2,
                 SZ_WPOOL = (size_t)2048 * 256 * 2, SZ_WSQ = (size_t)D * D * 2;
constexpr size_t WS_WFI = 1 * MiB;
constexpr size_t WS_WFO = WS_WFI + 4 * SZ_WFI;
constexpr size_t WS_WUQKA = WS_WFO + 4 * SZ_WFO;
constexpr size_t WS_WV = WS_WUQKA + 2 * SZ_WUQKA;
constexpr size_t WS_WRGG = WS_WV + 2 * SZ_WV;
constexpr size_t WS_WPOOL = WS_WRGG + 2 * SZ_WRGG;
constexpr size_t WS_WGO = WS_WPOOL + 2 * SZ_WPOOL;
constexpr size_t WS_WO = WS_WGO + 2 * SZ_WSQ;
constexpr size_t WS_XF = WS_WO + 2 * SZ_WSQ;
constexpr size_t WS_XB = WS_XF + (size_t)M * D * 4;
constexpr size_t WS_Y = WS_XB + (size_t)M * D * 2;
constexpr size_t WS_ACT = WS_Y + (size_t)M * D * 4;
constexpr size_t WS_HQ = WS_ACT + (size_t)M * FF * 2;
constexpr size_t WS_HR = WS_HQ + (size_t)M * 3072 * 2;
constexpr size_t WS_VT = WS_HR + (size_t)M * 6144 * 2;
constexpr size_t WS_ALO = WS_VT + (size_t)M * D * 2;
constexpr size_t WS_POOLED = WS_ALO + 1 * MiB;
constexpr size_t WS_QT = WS_POOLED + (size_t)M * 1024 * 2;
constexpr size_t WS_KT = WS_QT + (size_t)M * 1024 * 2;
constexpr size_t WS_KHT = WS_KT + (size_t)M * 1024 * 2;
constexpr size_t WS_GDEC = WS_KHT + (size_t)M * 1024 * 2;
constexpr size_t WS_ORAW = WS_GDEC + 1 * MiB;
constexpr size_t WS_OG = WS_ORAW + (size_t)M * D * 4;
constexpr size_t WS_YA = WS_OG + (size_t)M * D * 2;
constexpr size_t WS_MG = WS_YA + (size_t)M * D * 2;
constexpr size_t WS_END = WS_MG + (size_t)M * D * 2;
constexpr int CW_BAR = 4096;
constexpr int CW_QUEUE = 16384;

constexpr int RING_BYTES = 135168;
constexpr int LDSCTL_OFF = RING_BYTES, MISC_OFF = LDSCTL_OFF + 320;
constexpr int LDS_BYTES = 147456;

#define GAS __attribute__((address_space(1)))
#define LAS __attribute__((address_space(3)))
typedef unsigned short bf16;
typedef unsigned v4u __attribute__((ext_vector_type(4)));
typedef unsigned v2u __attribute__((ext_vector_type(2)));
typedef float f32x4 __attribute__((ext_vector_type(4)));
typedef float f32x2 __attribute__((ext_vector_type(2)));
typedef short bf16x8 __attribute__((ext_vector_type(8)));
typedef short bf16x4 __attribute__((ext_vector_type(4)));
typedef GAS unsigned gu32;
#define RLX_AGENT __ATOMIC_RELAXED, __HIP_MEMORY_SCOPE_AGENT
#define LDS_WAIT() asm volatile("s_waitcnt lgkmcnt(0)" ::: "memory")
#define VM_WAIT() asm volatile("s_waitcnt vmcnt(0)" ::: "memory")
__device__ __forceinline__ unsigned f2bf(float f) { unsigned u = __builtin_bit_cast(unsigned, f); return (u + 0x7fffu + ((u >> 16) & 1u)) >> 16; }
__device__ __forceinline__ unsigned pk2(float lo, float hi) { return pg8::cvt_pk_bf16(lo, hi); }
__device__ __forceinline__ float bf2f(bf16 b) { return __uint_as_float(((unsigned)b) << 16); }

#define XB_TMO      128
#define XB_XCNT(j)  (256  + 64 * (j))
#define XB_XSUB(j)  (1280 + 64 * (j))
#define XB_XGEN(j)  (2304 + 64 * (j))
#define XB_TOP      3328
#define XB_TOPGEN   3392
#define XCD_BAR_WORDS 3456
#define XB_SPIN_CAP (1u << 20)

__device__ __forceinline__ unsigned xb_ld(unsigned* p)              { return __hip_atomic_load(p, __ATOMIC_RELAXED, __HIP_MEMORY_SCOPE_AGENT); }
__device__ __forceinline__ unsigned xb_add(unsigned* p, unsigned v) { return __hip_atomic_fetch_add(p, v, __ATOMIC_RELAXED, __HIP_MEMORY_SCOPE_AGENT); }
__device__ __forceinline__ unsigned xb_xcc_id() { return (unsigned)__builtin_amdgcn_s_getreg((3 << 11) | 20) & 0xFu; }
#define XB_SPIN(cond, bar) do { unsigned _sp = 0; while (cond) { __builtin_amdgcn_s_sleep(1); \
    if ((++_sp & 255u) == 0u) { if (xb_ld(&(bar)[XB_TMO])) break; if (_sp > XB_SPIN_CAP) { atomicAdd(&(bar)[XB_TMO], 1u); break; } } } } while (0)

struct XcdBarrier { unsigned* bar; unsigned x; volatile LAS unsigned* st; };

__device__ __forceinline__ XcdBarrier xcd_barrier_post(unsigned* bar, volatile LAS unsigned* st) {
    XcdBarrier b; b.bar = bar; b.x = xb_xcc_id(); b.st = st;
    if (threadIdx.x == 0) (void)xb_add(&bar[XB_XCNT(b.x)], 1u);
    return b;
}
__device__ __forceinline__ void xcd_barrier_complete(unsigned* bar, unsigned x, unsigned& nloc, unsigned& nx) {
    const unsigned G = gridDim.x * gridDim.y * gridDim.z;
    unsigned sum, cnt, mine, sp = 0u;
    for (;;) {
        sum = 0u; cnt = 0u; mine = 0u;
#pragma unroll
        for (unsigned j = 0; j < 16; ++j) { const unsigned c = xb_ld(&bar[XB_XCNT(j)]); sum += c; cnt += (c > 0u) ? 1u : 0u; mine = (j == x) ? c : mine; }
        if (sum == G) break;
        __builtin_amdgcn_s_sleep(1);
        if ((++sp & 255u) == 0u) { if (xb_ld(&bar[XB_TMO])) break; if (sp > XB_SPIN_CAP) { atomicAdd(&bar[XB_TMO], 1u); break; } }
    }
    nloc = mine > 0u ? mine : 1u; nx = cnt > 0u ? cnt : 1u;
}
__device__ __forceinline__ void xcd_barrier(const XcdBarrier& b) {
    asm volatile("s_waitcnt vmcnt(0)" ::: "memory");
    __syncthreads();
    if (threadIdx.x == 0) {
        unsigned* bar = b.bar;
        __builtin_amdgcn_s_waitcnt(0);
        unsigned nloc = b.st[0], nx = b.st[1];
        if (nloc == 0u) { xcd_barrier_complete(bar, b.x, nloc, nx); b.st[0] = nloc; b.st[1] = nx; }
        const unsigned old = xb_add(&bar[XB_XSUB(b.x)], 1u);
        const unsigned gen = old / nloc;
        if (old + 1u == (gen + 1u) * nloc) {
            __builtin_amdgcn_fence(__ATOMIC_RELEASE, "agent");
            asm volatile("s_waitcnt vmcnt(0)" ::: "memory");
            const unsigned og = xb_add(&bar[XB_TOP], 1u);
            const unsigned tg = og / nx;
            if (og + 1u == (tg + 1u) * nx) xb_add(&bar[XB_TOPGEN], 1u);
            else XB_SPIN(xb_ld(&bar[XB_TOPGEN]) == tg, bar);
            __builtin_amdgcn_fence(__ATOMIC_ACQUIRE, "agent");
            xb_add(&bar[XB_XGEN(b.x)], 1u);
            asm volatile("s_waitcnt vmcnt(0)" ::: "memory");
        } else {
            XB_SPIN(xb_ld(&bar[XB_XGEN(b.x)]) == gen, bar);
            __builtin_amdgcn_fence(__ATOMIC_ACQUIRE, "agent");
            asm volatile("s_waitcnt vmcnt(0)" ::: "memory");
        }
    }
    __syncthreads();
}

struct Args { const float* in[16]; float* out; unsigned char* ws; int ph_lo, ph_hi; };
extern __shared__ __attribute__((aligned(16))) unsigned char lds_raw[];
constexpr int TAB_OFF = LDSCTL_OFF + 64;
#define LDSB ((LAS unsigned char*)lds_raw)
__device__ __forceinline__ GAS unsigned char* tab_ptr(int i) {
    volatile LAS unsigned* t = (volatile LAS unsigned*)(LDSB + TAB_OFF) + 2 * i;
    const unsigned lo = __builtin_amdgcn_readfirstlane(t[0]), hi = __builtin_amdgcn_readfirstlane(t[1]);
    return (GAS unsigned char*)(((unsigned long long)hi << 32) | lo);
}
#define TP(T, i) ((T*)tab_ptr(i))
#define TID ((int)threadIdx.x)
#define LANE ((int)(threadIdx.x & 63))
#define WAVE (__builtin_amdgcn_readfirstlane((int)(threadIdx.x >> 6)))
#define GRID ((int)gridDim.x)
#define BID ((int)blockIdx.x)
struct Frame {};
__device__ __forceinline__ int opaque_tid() { int t = threadIdx.x; asm volatile("" : "+v"(t)); return t; }
#define PHASE_IDS const int tid_o = opaque_tid(), lane_o = tid_o & 63, wave_o = __builtin_amdgcn_readfirstlane(tid_o >> 6)
__device__ __forceinline__ float wave_sum(float v) {
#pragma unroll
    for (int o = 1; o < 64; o <<= 1) v += __shfl_xor(v, o);
    return v;
}

__device__ __forceinline__ void transpose_item(const float* W, int ldw, int k0, int n0, bf16* WT, int ldd, int dst_row0, LAS float* scr, int lane) {
#pragma unroll 8
    for (int i = 0; i < 32; ++i) { const int kk = 2 * i + (lane >> 5); scr[kk * 33 + (lane & 31)] = W[(size_t)(k0 + kk) * ldw + n0 + (lane & 31)]; }
    LDS_WAIT(); asm volatile("" ::: "memory");
    const int c = lane & 7;
#pragma unroll
    for (int j = 0; j < 4; ++j) { const int n = (lane >> 3) + 8 * j; const LAS float* s = scr + (8 * c) * 33 + n;
        v4u o; o.x = pk2(s[0 * 33], s[1 * 33]); o.y = pk2(s[2 * 33], s[3 * 33]); o.z = pk2(s[4 * 33], s[5 * 33]); o.w = pk2(s[6 * 33], s[7 * 33]);
        *(GAS v4u*)(WT + (size_t)(dst_row0 + n) * ldd + k0 + 8 * c) = o; }
    LDS_WAIT(); asm volatile("" ::: "memory");
}
constexpr int IT_FI = (D / 64) * (FF2 / 32);
constexpr int IT_FO = (FF / 64) * (D / 32);
constexpr int IT_UQK = (D / 64) * (3072 / 32);
constexpr int IT_ALO = (D / 64);
constexpr int IT_V = (D / 64) * (2048 / 32);
constexpr int IT_RGG = (D / 64) * (6144 / 32);
constexpr int IT_POOL = 4 * (256 / 64) * (512 / 32);
constexpr int IT_SQ = (D / 64) * (D / 32);
constexpr int IT_LAYER = 2 * IT_FI + 2 * IT_FO + IT_UQK + IT_ALO + IT_V + IT_RGG + IT_POOL + 2 * IT_SQ;

__device__ __forceinline__ void p0_prologue(Frame& F) {
    PHASE_IDS;
    unsigned char* const ws = TP(unsigned char, 17);
    LAS float* scr = (LAS float*)(LDSB + wave_o * 16384);
    const int gw = BID * NWAVES + wave_o, NGW = GRID * NWAVES;
    const float* w_ffn_in = TP(const float, 6); const float* w_ffn_out = TP(const float, 7); const float* w_in = TP(const float, 8); const float* pool_w = TP(const float, 9);
    const float* w_gla_out = TP(const float, 14); const float* w_out = TP(const float, 15);
    for (int it = gw; it < 2 * IT_LAYER; it += NGW) {
        const int l = it / IT_LAYER; int r = it % IT_LAYER;
        if (r < 2 * IT_FI) { const int f = r / IT_FI; r %= IT_FI; const int nblk = FF2 / 32, kb = r / nblk, nb = r % nblk, n0 = 32 * nb, seg = n0 / FF, c = n0 % FF;
            transpose_item(w_ffn_in + (size_t)(l * 2 + f) * D * FF2, FF2, 64 * kb, n0, (bf16*)(ws + WS_WFI + (size_t)(l * 2 + f) * SZ_WFI), D, 256 * (c / 128) + 128 * seg + (c % 128), scr, lane_o); continue; }
        r -= 2 * IT_FI;
        if (r < 2 * IT_FO) { const int f = r / IT_FO; r %= IT_FO; const int nblk = D / 32, kb = r / nblk, nb = r % nblk;
            transpose_item(w_ffn_out + (size_t)(l * 2 + f) * FF * D, D, 64 * kb, 32 * nb, (bf16*)(ws + WS_WFO + (size_t)(l * 2 + f) * SZ_WFO), FF, 32 * nb, scr, lane_o); continue; }
        r -= 2 * IT_FO;
        const float* wi = w_in + (size_t)l * D * INW;
        if (r < IT_UQK) { const int nblk = 3072 / 32, kb = r / nblk, nb = r % nblk;
            transpose_item(wi, INW, 64 * kb, 32 * nb, (bf16*)(ws + WS_WUQKA + (size_t)l * SZ_WUQKA), D, 32 * nb, scr, lane_o); continue; }
        r -= IT_UQK;
        if (r < IT_ALO) { transpose_item(wi, INW, 64 * r, 5120, (bf16*)(ws + WS_WUQKA + (size_t)l * SZ_WUQKA), D, 3072, scr, lane_o); continue; }
        r -= IT_ALO;
        if (r < IT_V) { const int nblk = 2048 / 32, kb = r / nblk, nb = r % nblk;
            transpose_item(wi, INW, 64 * kb, 3072 + 32 * nb, (bf16*)(ws + WS_WV + (size_t)l * SZ_WV), D, 32 * nb, scr, lane_o); continue; }
        r -= IT_V;
        if (r < IT_RGG) { const int nblk = 6144 / 32, kb = r / nblk, nb = r % nblk;
            transpose_item(wi, INW, 64 * kb, 5136 + 32 * nb, (bf16*)(ws + WS_WRGG + (size_t)l * SZ_WRGG), D, 32 * nb, scr, lane_o); continue; }
        r -= IT_RGG;
        if (r < IT_POOL) { const int g = r / 64, rr = r % 64, kb = rr / 16, nb = rr % 16;
            transpose_item(pool_w + (size_t)(l * 4 + g) * 256 * 512, 512, 64 * kb, 32 * nb, (bf16*)(ws + WS_WPOOL + (size_t)l * SZ_WPOOL), 256, g * 512 + 32 * nb, scr, lane_o); continue; }
        r -= IT_POOL;
        if (r < IT_SQ) { const int nblk = D / 32, kb = r / nblk, nb = r % nblk;
            transpose_item(w_gla_out + (size_t)l * D * D, D, 64 * kb, 32 * nb, (bf16*)(ws + WS_WGO + (size_t)l * SZ_WSQ), D, 32 * nb, scr, lane_o); continue; }
        r -= IT_SQ;
        { const int nblk = D / 32, kb = r / nblk, nb = r % nblk;
            transpose_item(w_out + (size_t)l * D * D, D, 64 * kb, 32 * nb, (bf16*)(ws + WS_WO + (size_t)l * SZ_WSQ), D, 32 * nb, scr, lane_o); }
    }
    for (int l = 0; l < 2; ++l) { GAS v4u* z = (GAS v4u*)(ws + WS_WUQKA + (size_t)l * SZ_WUQKA + (size_t)3104 * D * 2); const int n16 = (3328 - 3104) * D * 2 / 16;
        for (int i = gw * 64 + lane_o; i < n16; i += NGW * 64) z[i] = (v4u){0u, 0u, 0u, 0u}; }
    const float* xp = TP(const float, 0); const float* xs = TP(const float, 1); bf16* XB = (bf16*)(ws + WS_XB);
    for (int m = gw; m < M; m += NGW) { const float* src = m < MP ? xp + (size_t)m * D : xs + (size_t)(m - MP) * D;
        const GAS f32x4* xr = (const GAS f32x4*)src + lane_o; GAS v2u* o8 = (GAS v2u*)(XB + (size_t)m * D) + lane_o;
#pragma unroll
        for (int j = 0; j < 8; ++j) { const f32x4 v = xr[64 * j]; o8[64 * j] = (v2u){pk2(v.x, v.y), pk2(v.z, v.w)}; } }
}

__device__ __forceinline__ void ln_phase(Frame& F, const float* Y, const float* g, const float* b, float* outF, bf16* outB) {
    PHASE_IDS;
    const int gw = BID * NWAVES + wave_o, NGW = GRID * NWAVES;
    for (int m = gw; m < M; m += NGW) {
        const GAS f32x4* xr = (const GAS f32x4*)(Y + (size_t)m * D) + lane_o;
        f32x4 v[8]; float s = 0.f;
#pragma unroll
        for (int j = 0; j < 8; ++j) { v[j] = xr[64 * j]; s += (v[j].x + v[j].y) + (v[j].z + v[j].w); }
        const float mean = wave_sum(s) * (1.f / D); float s2 = 0.f;
#pragma unroll
        for (int j = 0; j < 8; ++j) { v[j] = v[j] - mean; s2 += (v[j].x * v[j].x + v[j].y * v[j].y) + (v[j].z * v[j].z + v[j].w * v[j].w); }
        const float rstd = 1.f / sqrtf(wave_sum(s2) * (1.f / D) + LN_EPS);
        GAS f32x4* of = (GAS f32x4*)(outF + (size_t)m * D) + lane_o;
#pragma unroll
        for (int j = 0; j < 8; ++j) { const f32x4 gg = *((const f32x4*)g + lane_o + 64 * j), bb = *((const f32x4*)b + lane_o + 64 * j);
            v[j] = v[j] * rstd * gg + bb; of[64 * j] = v[j]; }
        if (outB) { GAS v2u* o8 = (GAS v2u*)(outB + (size_t)m * D) + lane_o;
#pragma unroll
            for (int j = 0; j < 8; ++j) o8[64 * j] = (v2u){pk2(v[j].x, v[j].y), pk2(v[j].z, v[j].w)}; }
    }
}

__device__ __forceinline__ void prepass_phase(Frame& F, int l) {
    PHASE_IDS;
    unsigned char* const ws = TP(unsigned char, 17); float* const outp = TP(float, 16);
    LAS float* tile = (LAS float*)(LDSB + wave_o * 16640);
    const int gw = BID * NWAVES + wave_o, NGW = GRID * NWAVES, lane = lane_o;
    const bf16* HQ = (const bf16*)(ws + WS_HQ); const float* ALO = (const float*)(ws + WS_ALO);
    bf16* QT = (bf16*)(ws + WS_QT); bf16* KT = (bf16*)(ws + WS_KT); bf16* KHT = (bf16*)(ws + WS_KHT); bf16* PO = (bf16*)(ws + WS_POOLED); float* GD = (float*)(ws + WS_GDEC);
    const float* state_pool = TP(const float, 2) + (size_t)l * DECB * PBUF * PW; const float* a_up = TP(const float, 11) + (size_t)l * RANK * GK; const float* a_bias = TP(const float, 12) + (size_t)l * GK;
    float* NPP = outp + O_NPP + (size_t)l * NB * PBUF * PW; float* NPS = outp + O_NPS + (size_t)l * DECB * PBUF * PW;
    for (int it = gw; it < 4096; it += NGW) {
        const bool samp = it >= 2048; const int r = it & 2047, cb = r & 15, cid = r >> 4;
        const int b = samp ? cid : (cid >> 5), ci = samp ? 0 : (cid & 31);
        const int t0 = samp ? MP + 8 * b : b * SEQ + 64 * ci, ntok = samp ? 8 : 64, pos0 = samp ? 0 : 64 * ci;
        const int c = 64 * cb + lane;
        float aup[16];
#pragma unroll
        for (int j = 0; j < 16; ++j) aup[j] = a_up[j * GK + c];
        const float ab = a_bias[c];
        float alo[16];
        { const int tr = lane < ntok ? lane : ntok - 1; const GAS f32x4* ap = (const GAS f32x4*)(ALO + (size_t)(t0 + tr) * 16);
#pragma unroll
          for (int j = 0; j < 4; ++j) { const f32x4 v = ap[j]; alo[4 * j] = v.x; alo[4 * j + 1] = v.y; alo[4 * j + 2] = v.z; alo[4 * j + 3] = v.w; } }
        const int w = 2 << (c >> 8);
        float wsum = 0.f;
        for (int j = 1; j < w; ++j) { const int p = pos0 - j;
            float e;
            if (p >= 0) e = bf2f(HQ[(size_t)(t0 - j) * 3072 + c]);
            else e = samp ? state_pool[((size_t)b * PBUF + (PBUF + p)) * PW + c] : 0.f;
            wsum += e; }
        if (samp) { for (int j = 0; j < 7; ++j) NPS[((size_t)b * PBUF + j) * PW + c] = state_pool[((size_t)b * PBUF + 8 + j) * PW + c]; }
        float bs = 0.f;
#pragma unroll 1
        for (int tb = 0; tb < ntok; tb += 8) {
            float uu[8], qq[8], kk[8], uo[8];
#pragma unroll
            for (int j = 0; j < 8; ++j) { const size_t row = (size_t)(t0 + tb + j);
                uu[j] = bf2f(HQ[row * 3072 + c]); qq[j] = bf2f(HQ[row * 3072 + 1024 + c]); kk[j] = bf2f(HQ[row * 3072 + 2048 + c]);
                const int p = pos0 + tb + j - w + 1;
                if (p >= 0) uo[j] = bf2f(HQ[(size_t)(t0 + tb + j - w + 1) * 3072 + c]);
                else uo[j] = samp ? state_pool[((size_t)b * PBUF + (PBUF + p)) * PW + c] : 0.f; }
#pragma unroll
            for (int j = 0; j < 8; ++j) { const int t = tb + j;
                float z = ab;
#pragma unroll
                for (int r = 0; r < 16; ++r) z += __uint_as_float(__builtin_amdgcn_readlane(__float_as_uint(alo[r]), t)) * aup[r];
                const float la = -(fmaxf(-z, 0.f) + log1pf(__expf(-fabsf(z)))) * 0.0625f;
                bs += la;
                const size_t row = (size_t)(t0 + t);
                const float uq = uu[j], qv = qq[j], kv = kk[j];
                const float eb = __expf(bs), enb = __expf(-bs);
                QT[row * 1024 + c] = (bf16)f2bf(qv * eb);
                const float kt = kv * enb;
                KT[row * 1024 + c] = (bf16)f2bf(kt);
                tile[lane * 65 + t] = kt;
                wsum += uq;
                const int pos = pos0 + t; const float cnt = samp ? (float)w : (float)(pos + 1 < w ? pos + 1 : w);
                PO[row * 1024 + c] = (bf16)f2bf(wsum / cnt - uq);
                wsum -= uo[j];
                if (samp) NPS[((size_t)b * PBUF + 7 + t) * PW + c] = uq;
                else if (ci == 31 && t >= 49) NPP[((size_t)b * PBUF + (t - 49)) * PW + c] = uq;
            }
        }
        const float gl = __expf(bs);
        GD[(size_t)((samp ? 128 : 0) + cid) * 1024 + c] = gl;
        LDS_WAIT(); asm volatile("" ::: "memory");
        const int tg = lane & 7;
#pragma unroll
        for (int i = 0; i < 8; ++i) { const int ch = 8 * i + (lane >> 3); const float gch = __shfl(gl, ch);
            if (8 * tg < ntok) { const LAS float* s = tile + ch * 65 + 8 * tg;
                v4u o; o.x = pk2(s[0] * gch, s[1] * gch); o.y = pk2(s[2] * gch, s[3] * gch); o.z = pk2(s[4] * gch, s[5] * gch); o.w = pk2(s[6] * gch, s[7] * gch);
                *(GAS v4u*)(KHT + (size_t)(64 * cb + ch) * M + t0 + 8 * tg) = o; } }
        LDS_WAIT(); asm volatile("" ::: "memory");
    }
}

#define BAR_LDS() do { asm volatile("s_waitcnt lgkmcnt(0)" ::: "memory"); __builtin_amdgcn_s_barrier(); asm volatile("" ::: "memory"); } while (0)
constexpr int GL_QS = 0, GL_ROW = 528, GL_KT = GL_QS + 64 * GL_ROW, GL_KH = GL_KT + 64 * GL_ROW, GL_KH_STRIDE = 144, GL_AL = GL_KH + 256 * GL_KH_STRIDE, GL_AL_STRIDE = 144,
              GL_G = GL_AL + 64 * GL_AL_STRIDE, GL_END = GL_G + 1024;
static_assert(GL_END <= RING_BYTES, "GLA LDS");
__device__ __forceinline__ void gla_prompt_unit(Frame& F, int l, int u) {
    PHASE_IDS;
    unsigned char* const ws = TP(unsigned char, 17);
    const int b = u >> 4, h = (u >> 2) & 3, vq = u & 3, w = wave_o, lane = lane_o, l15 = lane & 15, q = lane >> 4, tid = tid_o;
    const bf16* QT = (const bf16*)(ws + WS_QT); const bf16* KT = (const bf16*)(ws + WS_KT); const bf16* KHT = (const bf16*)(ws + WS_KHT); const bf16* VT = (const bf16*)(ws + WS_VT);
    const float* GD = (const float*)(ws + WS_GDEC); float* ORAW = (float*)(ws + WS_ORAW);
    const int vcol0 = h * 512 + vq * 128 + 16 * w;
    LAS unsigned char* lds = LDSB;
    f32x4 S[16];
#pragma unroll
    for (int i = 0; i < 16; ++i) S[i] = (f32x4){0.f, 0.f, 0.f, 0.f};
    v4u rq[4], rk[4], rh[4]; f32x4 rg = (f32x4){0.f, 0.f, 0.f, 0.f}; bf16x8 vfn[2];
#define GLP_LOAD(CI) do { const int t0n = b * SEQ + 64 * (CI); \
        _Pragma("unroll") for (int i = 0; i < 4; ++i) { const int p = tid + 512 * i, row = p >> 5, cs = p & 31; \
            rq[i] = *(const GAS v4u*)(QT + (size_t)(t0n + row) * 1024 + h * 256 + cs * 8); rk[i] = *(const GAS v4u*)(KT + (size_t)(t0n + row) * 1024 + h * 256 + cs * 8); } \
        _Pragma("unroll") for (int i = 0; i < 4; ++i) { const int p = tid + 512 * i, row = p >> 3, cs = p & 7; \
            rh[i] = *(const GAS v4u*)(KHT + (size_t)(h * 256 + row) * M + t0n + cs * 8); } \
        if (tid < 64) rg = *(const GAS f32x4*)(GD + (size_t)(b * 32 + (CI)) * 1024 + h * 256 + 4 * tid); \
        _Pragma("unroll") for (int s = 0; s < 2; ++s) vfn[s] = *(const GAS bf16x8*)(VT + (size_t)(vcol0 + l15) * M + t0n + 32 * s + 8 * q); } while (0)
    GLP_LOAD(0);
#pragma unroll 1
    for (int ci = 0; ci < 32; ++ci) {
        const int t0 = b * SEQ + 64 * ci;
        BAR_LDS();
#pragma unroll
        for (int i = 0; i < 4; ++i) { const int p = tid + 512 * i, row = p >> 5, cs = p & 31;
            *(LAS v4u*)(lds + GL_QS + row * GL_ROW + cs * 16) = rq[i]; *(LAS v4u*)(lds + GL_KT + row * GL_ROW + cs * 16) = rk[i]; }
#pragma unroll
        for (int i = 0; i < 4; ++i) { const int p = tid + 512 * i, row = p >> 3, cs = p & 7; *(LAS v4u*)(lds + GL_KH + row * GL_KH_STRIDE + cs * 16) = rh[i]; }
        if (tid < 64) *(LAS f32x4*)(lds + GL_G + 16 * tid) = rg;
        bf16x8 vf[2]; vf[0] = vfn[0]; vf[1] = vfn[1];
        if (ci + 1 < 32) GLP_LOAD(ci + 1);
        BAR_LDS();
        {
            const int it = w >> 1;
#pragma unroll
            for (int jj = 0; jj < 2; ++jj) { const int jt = 2 * (w & 1) + jj;
                f32x4 acc = (f32x4){0.f, 0.f, 0.f, 0.f};
                if (jt <= it) {
#pragma unroll
                    for (int sh = 0; sh < 2; ++sh) {
                        bf16x8 af[4], bfr[4];
#pragma unroll
                        for (int s = 0; s < 4; ++s) { af[s] = *(const LAS bf16x8*)(lds + GL_QS + (16 * it + l15) * GL_ROW + (32 * (4 * sh + s) + 8 * q) * 2);
                            bfr[s] = *(const LAS bf16x8*)(lds + GL_KT + (16 * jt + l15) * GL_ROW + (32 * (4 * sh + s) + 8 * q) * 2); }
                        __builtin_amdgcn_sched_barrier(0);
#pragma unroll
                        for (int s = 0; s < 4; ++s) acc = __builtin_amdgcn_mfma_f32_16x16x32_bf16(af[s], bfr[s], acc, 0, 0, 0);
                        __builtin_amdgcn_sched_barrier(0);
                    }
                }
#pragma unroll
                for (int r = 0; r < 4; ++r) { const int i = 16 * it + 4 * q + r, j = 16 * jt + l15; const float v = (j <= i) ? acc[r] : 0.f;
                    *(LAS bf16*)(lds + GL_AL + i * GL_AL_STRIDE + j * 2) = (bf16)f2bf(v); }
            }
        }
        BAR_LDS();
        f32x4 oT[4];
#pragma unroll
        for (int it = 0; it < 4; ++it) oT[it] = (f32x4){0.f, 0.f, 0.f, 0.f};
        {
            v2u qlo[2][4], qhi[2][4];
#define GLP_QF(buf, s) do { _Pragma("unroll") for (int it = 0; it < 4; ++it) { const LAS unsigned char* qp = lds + GL_QS + (16 * it + l15) * GL_ROW + (32 * (s) + 4 * q) * 2; \
                qlo[buf][it] = *(const LAS v2u*)qp; qhi[buf][it] = *(const LAS v2u*)(qp + 32); } } while (0)
            GLP_QF(0, 0);
#pragma unroll
            for (int s = 0; s < 8; ++s) {
                if (s + 1 < 8) GLP_QF((s + 1) & 1, s + 1);
                __builtin_amdgcn_sched_barrier(0);
                bf16x8 sf; { const f32x4 x0 = S[2 * s], x1 = S[2 * s + 1]; v4u wv; wv.x = pk2(x0[0], x0[1]); wv.y = pk2(x0[2], x0[3]); wv.z = pk2(x1[0], x1[1]); wv.w = pk2(x1[2], x1[3]); sf = __builtin_bit_cast(bf16x8, wv); }
#pragma unroll
                for (int it = 0; it < 4; ++it) {
                    const bf16x8 qf = __builtin_bit_cast(bf16x8, (v4u){qlo[s & 1][it].x, qlo[s & 1][it].y, qhi[s & 1][it].x, qhi[s & 1][it].y});
                    oT[it] = __builtin_amdgcn_mfma_f32_16x16x32_bf16(sf, qf, oT[it], 0, 0, 0);
                }
                __builtin_amdgcn_sched_barrier(0);
            }
#undef GLP_QF
        }
        {
            bf16x8 af[2][4];
#pragma unroll
            for (int s = 0; s < 2; ++s)
#pragma unroll
                for (int it = 0; it < 4; ++it) af[s][it] = *(const LAS bf16x8*)(lds + GL_AL + (16 * it + l15) * GL_AL_STRIDE + (32 * s + 8 * q) * 2);
            __builtin_amdgcn_sched_barrier(0);
#pragma unroll
            for (int s = 0; s < 2; ++s)
#pragma unroll
                for (int it = 0; it < 4; ++it) oT[it] = __builtin_amdgcn_mfma_f32_16x16x32_bf16(vf[s], af[s][it], oT[it], 0, 0, 0);
        }
#pragma unroll
        for (int it = 0; it < 4; ++it) *(GAS f32x4*)(ORAW + (size_t)(t0 + 16 * it + l15) * 2048 + vcol0 + 4 * q) = oT[it];
        {
            bf16x8 kf[2][2][2]; f32x4 gv[2][2];
#define GLP_KF(buf, kg) do { _Pragma("unroll") for (int kk = 0; kk < 2; ++kk) { const int kt = 2 * (kg) + kk; gv[buf][kk] = *(const LAS f32x4*)(lds + GL_G + (16 * kt + 4 * q) * 4); \
                _Pragma("unroll") for (int s = 0; s < 2; ++s) kf[buf][kk][s] = *(const LAS bf16x8*)(lds + GL_KH + (16 * kt + l15) * GL_KH_STRIDE + (32 * s + 8 * q) * 2); } } while (0)
            GLP_KF(0, 0);
#pragma unroll
            for (int kg = 0; kg < 8; ++kg) {
                if (kg + 1 < 8) GLP_KF((kg + 1) & 1, kg + 1);
                __builtin_amdgcn_sched_barrier(0);
#pragma unroll
                for (int kk = 0; kk < 2; ++kk) { const int kt = 2 * kg + kk;
                    f32x4 acc = S[kt] * gv[kg & 1][kk];
#pragma unroll
                    for (int s = 0; s < 2; ++s) acc = __builtin_amdgcn_mfma_f32_16x16x32_bf16(kf[kg & 1][kk][s], vf[s], acc, 0, 0, 0);
                    S[kt] = acc; }
                __builtin_amdgcn_sched_barrier(0);
            }
#undef GLP_KF
        }
    }
#undef GLP_LOAD
    float* NG = TP(float, 16) + O_NGP + ((size_t)((l * NB + b) * GH + h) * DK) * DV;
#pragma unroll
    for (int kt = 0; kt < 16; ++kt)
#pragma unroll
        for (int r = 0; r < 4; ++r) NG[(size_t)(16 * kt + 4 * q + r) * DV + vq * 128 + 16 * w + l15] = S[kt][r];
    BAR_LDS();
}

constexpr int GS_REC = 0, GS_REC_STRIDE = 20  , GS_A = 256 * GS_REC_STRIDE * 4, GS_KT = GS_A + 64 * 4, GS_RED = GS_KT + 8 * 257 * 4, GS_END = GS_RED + 4 * 8 * 512 * 4;
static_assert(GS_END <= RING_BYTES, "GLA sample LDS");
__device__ __forceinline__ void gla_sample_unit(Frame& F, int l, int u) {
    PHASE_IDS;
    unsigned char* const ws = TP(unsigned char, 17);
    const int b = u >> 2, h = u & 3, tid = tid_o;
    const bf16* QT = (const bf16*)(ws + WS_QT); const bf16* KT = (const bf16*)(ws + WS_KT); const bf16* KHT = (const bf16*)(ws + WS_KHT); const bf16* VT = (const bf16*)(ws + WS_VT);
    const float* GD = (const float*)(ws + WS_GDEC); float* ORAW = (float*)(ws + WS_ORAW);
    const float* S0 = TP(const float, 3) + ((size_t)((l * DECB + b) * GH + h) * DK) * DV; float* S1 = TP(float, 16) + O_NGS + ((size_t)((l * DECB + b) * GH + h) * DK) * DV;
    LAS float* rec = (LAS float*)(LDSB + GS_REC);
    LAS float* Am = (LAS float*)(LDSB + GS_A);
    LAS float* kts = (LAS float*)(LDSB + GS_KT);
    LAS float* red = (LAS float*)(LDSB + GS_RED);
    const int row0 = MP + 8 * b;
    const int c4 = tid & 127, kq = tid >> 7;
    const GAS f32x4* sp = (const GAS f32x4*)(S0 + (size_t)(64 * kq) * DV) + c4; GAS f32x4* dp = (GAS f32x4*)(S1 + (size_t)(64 * kq) * DV) + c4;
    f32x4 cur[8], nxt[8];
#pragma unroll
    for (int j = 0; j < 8; ++j) cur[j] = __builtin_nontemporal_load(sp + (size_t)j * (DV / 4));
    __syncthreads();
    { const int i = tid >> 6, k4 = (tid & 63) * 4;
      const v2u qw = *(const GAS v2u*)(QT + (size_t)(row0 + i) * 1024 + h * 256 + k4); const v2u kw = *(const GAS v2u*)(KT + (size_t)(row0 + i) * 1024 + h * 256 + k4);
      rec[(k4 + 0) * GS_REC_STRIDE + i] = pg8::bf_lo(qw.x); rec[(k4 + 1) * GS_REC_STRIDE + i] = pg8::bf_hi(qw.x); rec[(k4 + 2) * GS_REC_STRIDE + i] = pg8::bf_lo(qw.y); rec[(k4 + 3) * GS_REC_STRIDE + i] = pg8::bf_hi(qw.y);
      kts[i * 257 + k4 + 0] = pg8::bf_lo(kw.x); kts[i * 257 + k4 + 1] = pg8::bf_hi(kw.x); kts[i * 257 + k4 + 2] = pg8::bf_lo(kw.y); kts[i * 257 + k4 + 3] = pg8::bf_hi(kw.y); }
    if (tid < 256) { const int k = tid; const v4u kh = *(const GAS v4u*)(KHT + (size_t)(h * 256 + k) * M + row0);
      LAS float* rp = rec + k * GS_REC_STRIDE + 8;
      rp[0] = pg8::bf_lo(kh.x); rp[1] = pg8::bf_hi(kh.x); rp[2] = pg8::bf_lo(kh.y); rp[3] = pg8::bf_hi(kh.y); rp[4] = pg8::bf_lo(kh.z); rp[5] = pg8::bf_hi(kh.z); rp[6] = pg8::bf_lo(kh.w); rp[7] = pg8::bf_hi(kh.w);
      rp[8] = GD[(size_t)(128 + b) * 1024 + h * 256 + k]; }
    float vv[8][4];
#pragma unroll
    for (int e = 0; e < 4; ++e) { const v4u t = *(const GAS v4u*)(VT + (size_t)(h * 512 + 4 * c4 + e) * M + row0);
        vv[0][e] = pg8::bf_lo(t.x); vv[1][e] = pg8::bf_hi(t.x); vv[2][e] = pg8::bf_lo(t.y); vv[3][e] = pg8::bf_hi(t.y); vv[4][e] = pg8::bf_lo(t.z); vv[5][e] = pg8::bf_hi(t.z); vv[6][e] = pg8::bf_lo(t.w); vv[7][e] = pg8::bf_hi(t.w); }
    __syncthreads();
    if (tid < 64) { const int i = tid >> 3, j = tid & 7; float s = 0.f;
      if (j <= i) for (int k = 0; k < 256; ++k) s += rec[k * GS_REC_STRIDE + i] * kts[j * 257 + k];
      Am[tid] = s; }
    f32x4 o[8];
#pragma unroll
    for (int i = 0; i < 8; ++i) o[i] = (f32x4){0.f, 0.f, 0.f, 0.f};
#pragma unroll 1
    for (int kb = 0; kb < 8; ++kb) {
        if (kb + 1 < 8) {
#pragma unroll
            for (int j = 0; j < 8; ++j) nxt[j] = __builtin_nontemporal_load(sp + (size_t)(8 * (kb + 1) + j) * (DV / 4));
        }
#pragma unroll
        for (int j = 0; j < 8; ++j) {
            const int kk = 8 * kb + j; const f32x4 s0 = cur[j];
            const LAS f32x4* rp = (const LAS f32x4*)(rec + (64 * kq + kk) * GS_REC_STRIDE);
            const f32x4 q0 = rp[0], q1 = rp[1], k0 = rp[2], k1 = rp[3]; const float g = rec[(64 * kq + kk) * GS_REC_STRIDE + 16];
            f32x4 sn = s0 * g;
#pragma unroll
            for (int jj = 0; jj < 4; ++jj) { const f32x4 v = (f32x4){vv[jj][0], vv[jj][1], vv[jj][2], vv[jj][3]}; sn += v * k0[jj]; }
#pragma unroll
            for (int jj = 0; jj < 4; ++jj) { const f32x4 v = (f32x4){vv[4 + jj][0], vv[4 + jj][1], vv[4 + jj][2], vv[4 + jj][3]}; sn += v * k1[jj]; }
#pragma unroll
            for (int i = 0; i < 4; ++i) { o[i] += s0 * q0[i]; o[4 + i] += s0 * q1[i]; }
            __builtin_nontemporal_store(sn, dp + (size_t)kk * (DV / 4));
        }
#pragma unroll
        for (int j = 0; j < 8; ++j) cur[j] = nxt[j];
    }
#pragma unroll
    for (int i = 0; i < 8; ++i) *(LAS f32x4*)(red + ((kq * 8 + i) * 512 + 4 * c4)) = o[i];
    __syncthreads();
#pragma unroll
    for (int rr = 0; rr < 2; ++rr) { const int idx = tid + 512 * rr, i = idx >> 7, cg = idx & 127;
        f32x4 acc = *(const LAS f32x4*)(red + ((0 * 8 + i) * 512 + 4 * cg)) + *(const LAS f32x4*)(red + ((1 * 8 + i) * 512 + 4 * cg)) + *(const LAS f32x4*)(red + ((2 * 8 + i) * 512 + 4 * cg)) + *(const LAS f32x4*)(red + ((3 * 8 + i) * 512 + 4 * cg));
#pragma unroll
        for (int j = 0; j < 8; ++j) { const float aij = (j <= i) ? Am[i * 8 + j] : 0.f; acc += (f32x4){vv[j][0], vv[j][1], vv[j][2], vv[j][3]} * aij; }
        *(GAS f32x4*)(ORAW + (size_t)(row0 + i) * 2048 + h * 512 + 4 * cg) = acc; }
}

__device__ __forceinline__ void postnorm_phase(Frame& F, int l) {
    PHASE_IDS;
    unsigned char* const ws = TP(unsigned char, 17);
    const int gw = BID * NWAVES + wave_o, NGW = GRID * NWAVES, lane = lane_o;
    const float* ORAW = (const float*)(ws + WS_ORAW); const bf16* HR = (const bf16*)(ws + WS_HR); bf16* OG = (bf16*)(ws + WS_OG); const float* hg = TP(const float, 13) + (size_t)l * GV;
    for (int m = gw; m < M; m += NGW) {
        const GAS f32x4* orow = (const GAS f32x4*)(ORAW + (size_t)m * 2048);
        f32x4 v[8]; float rs[4];
#pragma unroll
        for (int hh = 0; hh < 4; ++hh) { v[2 * hh] = orow[hh * 128 + lane]; v[2 * hh + 1] = orow[hh * 128 + 64 + lane];
            float s = 0.f;
#pragma unroll
            for (int e = 0; e < 4; ++e) s += v[2 * hh][e] * v[2 * hh][e] + v[2 * hh + 1][e] * v[2 * hh + 1][e];
            rs[hh] = 1.f / sqrtf(wave_sum(s) * (1.f / 512.f) + HN_EPS); }
#pragma unroll
        for (int j = 0; j < 8; ++j) { const int col = (j >> 1) * 512 + (j & 1) * 256 + 4 * lane;
            const f32x4 g4 = *(const f32x4*)(hg + col); const v2u rw = *(const GAS v2u*)(HR + (size_t)m * 6144 + col);
            const f32x4 x = v[j] * rs[j >> 1] * g4;
            *(GAS v2u*)(OG + (size_t)m * 2048 + col) = (v2u){pk2(x[0] * pg8::bf_lo(rw.x), x[1] * pg8::bf_hi(rw.x)), pk2(x[2] * pg8::bf_lo(rw.y), x[3] * pg8::bf_hi(rw.y))}; }
    }
}

constexpr int N_PHASES = 27;
#ifndef REP_P0
#define REP_P0 1
#endif
#ifndef REP_FFI
#define REP_FFI 1
#endif
#ifndef REP_FFO
#define REP_FFO 1
#endif
#ifndef REP_LN
#define REP_LN 1
#endif
#ifndef REP_MIXIN
#define REP_MIXIN 1
#endif
#ifndef REP_PRE
#define REP_PRE 1
#endif
#ifndef REP_GLA
#define REP_GLA 1
#endif
#ifndef REP_POST
#define REP_POST 1
#endif
#ifndef REP_GLAP
#define REP_GLAP 1
#endif
#ifndef REP_GLAS
#define REP_GLAS 1
#endif
#ifndef REP_GO
#define REP_GO 1
#endif
#ifndef REP_WO
#define REP_WO 1
#endif
#define WSP(T, off) ((T*)(TP(unsigned char, 17) + (off)))
__global__ void __launch_bounds__(NWAVES * 64, 2) mega_fwd(Args args) {
    Frame F;
    for (int u = TID; u < (LDS_BYTES - LDSCTL_OFF) / 4; u += NWAVES * 64) ((LAS unsigned*)(LDSB + LDSCTL_OFF))[u] = 0u;
    __syncthreads();
    if (TID == 0) {
        LAS unsigned long long* tab = (LAS unsigned long long*)(LDSB + TAB_OFF);
#pragma unroll
        for (int i = 0; i < 16; ++i) tab[i] = (unsigned long long)args.in[i];
        tab[16] = (unsigned long long)args.out; tab[17] = (unsigned long long)args.ws;
    }
    const int lo = args.ph_lo, hi = args.ph_hi;
    __syncthreads();
    if (hi - lo > 1) (void)xcd_barrier_post(WSP(unsigned, WS_CTL) + CW_BAR, (volatile LAS unsigned*)(LDSB + MISC_OFF) + 8);
#define IN(k) (lo <= (k) && (k) < hi)
#define GRIDBAR() do { XcdBarrier bar_; bar_.bar = WSP(unsigned, WS_CTL) + CW_BAR; bar_.x = xb_xcc_id(); bar_.st = (volatile LAS unsigned*)(LDSB + MISC_OFF) + 8; xcd_barrier(bar_); } while (0)
#define REPEAT(n) _Pragma("unroll 1") for (int rep_ = 0; rep_ < (n); ++rep_)
#define REPBAR() do { if (rep_) GRIDBAR(); } while (0)
#define SEAM(k) do { if (IN(k) && IN((k) + 1)) { XcdBarrier bar_; bar_.bar = WSP(unsigned, WS_CTL) + CW_BAR; bar_.x = xb_xcc_id(); bar_.st = (volatile LAS unsigned*)(LDSB + MISC_OFF) + 8; xcd_barrier(bar_); } } while (0)
    int ph = 0;
#ifndef SKIP_P0
    if (IN(ph)) REPEAT(REP_P0) { REPBAR(); p0_prologue(F); }
#endif
    SEAM(ph); ++ph;
#pragma unroll 1
    for (int l = 0; l < 2; ++l) {
#pragma unroll 1
        for (int f = 0; f < 2; ++f) {
            if (IN(ph)) REPEAT(REP_FFI) { REPBAR();
#ifndef SKIP_FFI
                pg8::Gemm g{WSP(const bf16, WS_XB), WSP(const bf16, WS_WFI + (size_t)(l * 2 + f) * SZ_WFI), M, FF2, D, D, D, 31, 0};
                pg8::StaticOrder S; S.init(M, FF2, GRID, BID);
                pg8::EpiSwiGLU E{WSP(bf16, WS_ACT), FF};
                pg8::gemm_phase<pg8::EpiSwiGLU, pg8::StaticOrder>(LDSB, g, S, E);
#endif
            } SEAM(ph); ++ph;
            if (IN(ph)) REPEAT(REP_FFO) { REPBAR();
#ifndef SKIP_FFO
                pg8::Gemm g{WSP(const bf16, WS_ACT), WSP(const bf16, WS_WFO + (size_t)(l * 2 + f) * SZ_WFO), M, D, FF, FF, FF, 31, 0};
                pg8::StaticOrder S; S.init(M, D, GRID, BID);
                const bool first = (l == 0 && f == 0);
                pg8::EpiResid E{WSP(float, WS_Y), first ? TP(const float, 0) : WSP(const float, WS_XF), first ? TP(const float, 1) : WSP(const float, WS_XF) + (size_t)MP * D, MP, ALPHA, 0.5f};
                pg8::gemm_phase<pg8::EpiResid, pg8::StaticOrder>(LDSB, g, S, E);
#endif
            } SEAM(ph); ++ph;
            if (IN(ph)) REPEAT(REP_LN) { REPBAR();
#ifndef SKIP_LN
                const int idx = (f == 0) ? 0 : 2; const bool fin = (l == 1 && f == 1);
                ln_phase(F, WSP(const float, WS_Y), TP(const float, 4) + (size_t)(l * 3 + idx) * D, TP(const float, 5) + (size_t)(l * 3 + idx) * D, fin ? TP(float, 16) + O_Y : WSP(float, WS_XF), fin ? nullptr : WSP(bf16, WS_XB));
#endif
            } SEAM(ph); ++ph;
            if (f == 0) {
                if (IN(ph)) REPEAT(REP_MIXIN) { REPBAR();
#ifndef SKIP_UQKA
                    { pg8::Gemm g{WSP(const bf16, WS_XB), WSP(const bf16, WS_WUQKA + (size_t)l * SZ_WUQKA), M, 3328, D, D, D, 31, 0};
                      pg8::StaticOrder S; S.init(M, 3328, GRID, BID);
                      pg8::EpiUqka E{WSP(bf16, WS_HQ), WSP(float, WS_ALO)};
                      pg8::gemm_phase<pg8::EpiUqka, pg8::StaticOrder>(LDSB, g, S, E); }
#endif
#ifndef SKIP_RGG
                    { pg8::Gemm g{WSP(const bf16, WS_XB), WSP(const bf16, WS_WRGG + (size_t)l * SZ_WRGG), M, 6144, D, D, D, 31, 0};
                      pg8::StaticOrder S; S.init(M, 6144, GRID, (BID + GRID - 208) % GRID);
                      pg8::EpiRgg E{WSP(bf16, WS_HR)};
                      pg8::gemm_phase<pg8::EpiRgg, pg8::StaticOrder>(LDSB, g, S, E); }
#endif
#ifndef SKIP_VT
                    { pg8::Gemm g{WSP(const bf16, WS_WV + (size_t)l * SZ_WV), WSP(const bf16, WS_XB), D, M, D, D, D, 31, 0};
                      pg8::StaticOrder S; S.init(D, M, GRID, (BID + GRID - 48) % GRID);
                      pg8::EpiBf16 E{WSP(bf16, WS_VT), M};
                      pg8::gemm_phase<pg8::EpiBf16, pg8::StaticOrder>(LDSB, g, S, E); }
#endif
                } SEAM(ph); ++ph;
#ifndef SKIP_PRE
                if (IN(ph)) REPEAT(REP_PRE) { REPBAR(); prepass_phase(F, l); }
#endif
                SEAM(ph); ++ph;
                if (IN(ph)) REPEAT(REP_GLA) { REPBAR();
#ifndef SKIP_GLAP
                    if (BID < 64) { _Pragma("unroll 1") for (int rp_ = 0; rp_ < REP_GLAP; ++rp_) gla_prompt_unit(F, l, BID); }
#endif
                    LAS unsigned* qslot = (LAS unsigned*)(LDSB + LDSCTL_OFF);
                    _Pragma("unroll 1") for (int rs_ = 0; rs_ < REP_GLAS; ++rs_)
                    for (;;) {
                        __syncthreads();
                        if (TID == 0) qslot[0] = __hip_atomic_fetch_add(WSP(unsigned, WS_CTL) + CW_QUEUE + 64 * (l + 2 * rep_ + 4 * rs_), 1u, RLX_AGENT);
                        __syncthreads();
                        const unsigned u = ((volatile LAS unsigned*)qslot)[0];
                        if (u >= 512u) break;
#ifndef SKIP_GLAS
                        gla_sample_unit(F, l, (int)u);
#endif
                    }
                } SEAM(ph); ++ph;
                if (IN(ph)) REPEAT(REP_POST) { REPBAR();
#ifndef SKIP_POSTN
                    postnorm_phase(F, l);
#endif
                    __syncthreads();
#ifndef SKIP_POOL
                    int kpool = 256; asm volatile("" : "+s"(kpool));
                    pg8::Gemm g{WSP(const bf16, WS_POOLED), WSP(const bf16, WS_WPOOL + (size_t)l * SZ_WPOOL), M, D, kpool, 1024, 256, 1, 256};
                    pg8::StaticOrder S; S.init(M, D, GRID, BID);
                    pg8::EpiPool E{WSP(bf16, WS_YA), WSP(const bf16, WS_HR), TP(const float, 10) + (size_t)l * D};
                    pg8::gemm_phase<pg8::EpiPool, pg8::StaticOrder>(LDSB, g, S, E);
#endif
                } SEAM(ph); ++ph;
                if (IN(ph)) REPEAT(REP_GO) { REPBAR();
#ifndef SKIP_GO
                    pg8::Gemm g{WSP(const bf16, WS_OG), WSP(const bf16, WS_WGO + (size_t)l * SZ_WSQ), M, D, D, D, D, 31, 0};
                    pg8::StaticOrder S; S.init(M, D, GRID, BID);
                    pg8::EpiMerge E{WSP(bf16, WS_MG), WSP(const bf16, WS_YA), WSP(const bf16, WS_HR)};
                    pg8::gemm_phase<pg8::EpiMerge, pg8::StaticOrder>(LDSB, g, S, E);
#endif
                } SEAM(ph); ++ph;
                if (IN(ph)) REPEAT(REP_WO) { REPBAR();
#ifndef SKIP_WO
                    pg8::Gemm g{WSP(const bf16, WS_MG), WSP(const bf16, WS_WO + (size_t)l * SZ_WSQ), M, D, D, D, D, 31, 0};
                    pg8::StaticOrder S; S.init(M, D, GRID, BID);
                    pg8::EpiResid E{WSP(float, WS_Y), WSP(const float, WS_XF), WSP(const float, WS_XF) + (size_t)MP * D, MP, ALPHA, 1.0f};
                    pg8::gemm_phase<pg8::EpiResid, pg8::StaticOrder>(LDSB, g, S, E);
#endif
                } SEAM(ph); ++ph;
#ifndef SKIP_LN2
                if (IN(ph)) { ln_phase(F, WSP(const float, WS_Y), TP(const float, 4) + (size_t)(l * 3 + 1) * D, TP(const float, 5) + (size_t)(l * 3 + 1) * D, WSP(float, WS_XF), WSP(bf16, WS_XB)); }
#endif
                SEAM(ph); ++ph;
            }
        }
    }
#undef IN
#undef SEAM
}

extern "C" void kernel_launch(void* const* d_in, const int* in_sizes, int n_in, void* d_out, int out_size, void* d_ws, size_t ws_size, hipStream_t stream) {
    static int grid = 0;
    if (grid == 0) {
        if (n_in != 16 || (size_t)out_size != O_END || ws_size < WS_END) { fprintf(stderr, "kernel_launch: unexpected shapes (n_in %d out %d ws %zu need %zu)\n", n_in, out_size, ws_size, (size_t)WS_END); grid = -1; return; }
        int dev = 0, cus = 0, per_cu = 0;
        if (hipGetDevice(&dev) != hipSuccess || hipDeviceGetAttribute(&cus, hipDeviceAttributeMultiprocessorCount, dev) != hipSuccess) { grid = -1; return; }
        if (hipFuncSetAttribute((const void*)mega_fwd, hipFuncAttributeMaxDynamicSharedMemorySize, LDS_BYTES) != hipSuccess) { fprintf(stderr, "kernel_launch: hipFuncSetAttribute failed\n"); grid = -1; return; }
        if (hipOccupancyMaxActiveBlocksPerMultiprocessor(&per_cu, (const void*)mega_fwd, NWAVES * 64, LDS_BYTES) != hipSuccess || per_cu < 1)
            fprintf(stderr, "kernel_launch: occupancy query reports %d workgroups per CU\n", per_cu);
        (void)hipGetLastError();
        grid = cus;
    }
    if (grid < 0) return;
    if (hipMemsetAsync((char*)d_ws + WS_CTL, 0, CTL_ZERO_BYTES, stream) != hipSuccess) return;
    Args a{};
    for (int i = 0; i < 16; ++i) a.in[i] = (const float*)d_in[i];
    a.out = (float*)d_out; a.ws = (unsigned char*)d_ws;
#if MK_PER_PHASE
    for (int p = 0; p < N_PHASES; ++p) { a.ph_lo = p; a.ph_hi = p + 1; hipLaunchKernelGGL(mega_fwd, dim3(grid), dim3(NWAVES * 64), LDS_BYTES, stream, a); }
#else
    a.ph_lo = 0; a.ph_hi = N_PHASES;
    hipLaunchKernelGGL(mega_fwd, dim3(grid), dim3(NWAVES * 64), LDS_BYTES, stream, a);
#endif
}
```

```cpp
#include <hip/hip_runtime.h>
#include <cstdio>
#include <cstdint>

#ifndef MK_PER_PHASE
#define MK_PER_PHASE 0
#endif

namespace pg8 {
#define PG8_LAS __attribute__((address_space(3)))
typedef unsigned short bf16_t;
typedef short bf16x8 __attribute__((ext_vector_type(8)));
typedef float f32x4 __attribute__((ext_vector_type(4)));
typedef unsigned u32x4 __attribute__((ext_vector_type(4)));
typedef unsigned u32x2 __attribute__((ext_vector_type(2)));
typedef float f32x2 __attribute__((ext_vector_type(2)));
constexpr int BM = 256, BK = 64, HALF = 128, HTB = HALF * BK * 2  , STAGE_BYTES = 8 * HTB, NXCD = 8, WGM = 8;

__host__ __device__ __forceinline__ int lds_byte(int r, int c) { const int st = (r >> 4) * 2 + (c >> 5), rr = r & 15, cc = c & 31, ob = rr * 64 + cc * 2; return st * 1024 + (ob ^ (((ob >> 9) & 1) << 5)); }
__host__ __device__ __forceinline__ void stage_rc(int b, int& R, int& C) { const int st = b / 1024, sb = b % 1024, swz = sb ^ (((sb >> 9) & 1) << 5); R = (st >> 1) * 16 + swz / 64; C = (st & 1) * 32 + (swz % 64) / 2; }
__host__ __device__ __forceinline__ int perm32(int rho) { const int n = rho >> 4, i = rho & 15; return 8 * (i >> 2) + 4 * n + (i & 3); }

struct Unit { int pm, pn; };
struct Gemm { const bf16_t* A; const bf16_t* Bt; int M, N, K, lda, ldb, a_shift, a_mul; };

struct StaticOrder {
    int nM, nN, nwg, G, c;
    __host__ __device__ void init(int M, int N, int G_, int c_) { nM = M / BM; nN = N / BM; nwg = nM * nN; G = G_; c = c_; }
    __host__ __device__ bool next(int i, Unit& u) const {
        const long L = (long)i * G + c; if (L >= nwg) return false;
        int wgid = (int)L; { const int q = nwg / NXCD, r = nwg % NXCD, xcd = wgid % NXCD, off = wgid / NXCD; wgid = (xcd < r ? xcd * (q + 1) : r * (q + 1) + (xcd - r) * q) + off; }
        const int nig = WGM * nN, gid = wgid / nig, fm = gid * WGM, gsz = (nM - fm) < WGM ? (nM - fm) : WGM;
        u.pm = fm + ((wgid % nig) % gsz); u.pn = (wgid % nig) / gsz; return true;
    }
    __device__ __forceinline__ void a_ready(const Unit&) const {}
    __device__ __forceinline__ void done(const Unit&) const {}
};

__device__ __forceinline__ unsigned cvt_pk_bf16(float lo, float hi) { unsigned r; asm volatile("v_cvt_pk_bf16_f32 %0, %1, %2" : "=v"(r) : "v"(lo), "v"(hi)); return r; }
__device__ __forceinline__ float bf_lo(unsigned w) { return __uint_as_float(w << 16); }
__device__ __forceinline__ float bf_hi(unsigned w) { return __uint_as_float(w & 0xffff0000u); }
__device__ __forceinline__ float sigmoidf_(float x) { return __builtin_amdgcn_rcpf(1.0f + __expf(-x)); }
__device__ __forceinline__ float siluf_(float x) { return x * sigmoidf_(x); }


struct LnFold {
    const float* stat;
    const float* c1; const float* c2;
    __device__ __forceinline__ void row_stats(int row, float& mu, float& rstd) const {
        if (stat) { const f32x2 s = *(const f32x2*)(stat + 2 * (size_t)row); mu = s.x * (1.0f / 2048.0f); const float var = s.y * (1.0f / 2048.0f) - mu * mu; rstd = __builtin_amdgcn_rsqf(var + 1e-5f); }
        else { mu = 0.f; rstd = 1.f; }
    }
};
struct EpiVT {
    static constexpr bool PERM = true;
    bf16_t* O; int ldc; LnFold L;
    __device__ __forceinline__ void operator()(const f32x4 (&acc)[2][2][4][2], const Unit& u, int wr, int wc, int fr, int fq) const {
        const int row0 = u.pm * BM + wr * 64 + fr, col0 = u.pn * BM + wc * 32 + 8 * fq;
#pragma unroll
        for (int bj = 0; bj < 2; ++bj) {
            float mu[8], rs[8];
#pragma unroll
            for (int e = 0; e < 8; ++e) L.row_stats(col0 + bj * HALF + e, mu[e], rs[e]);
#pragma unroll
            for (int ai = 0; ai < 2; ++ai)
#pragma unroll
                for (int m = 0; m < 4; ++m) { const int r = row0 + ai * HALF + m * 16; const float a1 = L.c1[r], a2 = L.c2[r];
                    float o[8];
#pragma unroll
                    for (int n = 0; n < 2; ++n)
#pragma unroll
                        for (int e = 0; e < 4; ++e) o[4 * n + e] = rs[4 * n + e] * (acc[ai][bj][m][n][e] - mu[4 * n + e] * a1) + a2;
                    u32x4 w; w.x = cvt_pk_bf16(o[0], o[1]); w.y = cvt_pk_bf16(o[2], o[3]); w.z = cvt_pk_bf16(o[4], o[5]); w.w = cvt_pk_bf16(o[6], o[7]);
                    *(u32x4*)(O + (size_t)r * ldc + col0 + bj * HALF) = w; }
        }
    }
};
struct EpiSwiGLU {
    static constexpr bool PERM = true;
    bf16_t* O; int ldc; LnFold L;
    __device__ __forceinline__ void operator()(const f32x4 (&acc)[2][2][4][2], const Unit& u, int wr, int wc, int fr, int fq) const {
        const int row0 = u.pm * BM + wr * 64 + fr, col0 = u.pn * HALF + wc * 32 + 8 * fq, brow0 = u.pn * BM + wc * 32 + 8 * fq;
        f32x4 cg1[2], cg2[2], cu1[2], cu2[2];
#pragma unroll
        for (int n = 0; n < 2; ++n) { cg1[n] = *(const f32x4*)(L.c1 + brow0 + 4 * n); cg2[n] = *(const f32x4*)(L.c2 + brow0 + 4 * n); cu1[n] = *(const f32x4*)(L.c1 + brow0 + HALF + 4 * n); cu2[n] = *(const f32x4*)(L.c2 + brow0 + HALF + 4 * n); }
#pragma unroll
        for (int ai = 0; ai < 2; ++ai)
#pragma unroll
            for (int m = 0; m < 4; ++m) { const int r = row0 + ai * HALF + m * 16; float mu, rs; L.row_stats(r, mu, rs);
                float o[8];
#pragma unroll
                for (int n = 0; n < 2; ++n)
#pragma unroll
                    for (int e = 0; e < 4; ++e) { const float gt = rs * (acc[ai][0][m][n][e] - mu * cg1[n][e]) + cg2[n][e], up = rs * (acc[ai][1][m][n][e] - mu * cu1[n][e]) + cu2[n][e]; o[4 * n + e] = siluf_(gt) * up; }
                u32x4 w; w.x = cvt_pk_bf16(o[0], o[1]); w.y = cvt_pk_bf16(o[2], o[3]); w.z = cvt_pk_bf16(o[4], o[5]); w.w = cvt_pk_bf16(o[6], o[7]);
                *(u32x4*)(O + (size_t)r * ldc + col0) = w; }
    }
};
struct EpiResid {
    static constexpr bool PERM = true;
    float* Y; bf16_t* YB; float* stat_new;
    const float* xA; const float* xB; int split;
    const float* stat_old; const float* g; const float* b;
    float alpha, s;
    __device__ __forceinline__ void operator()(const f32x4 (&acc)[2][2][4][2], const Unit& u, int wr, int wc, int fr, int fq) const {
        const int row0 = u.pm * BM + wr * 64 + fr, col0 = u.pn * BM + wc * 32 + 8 * fq;
        const float* xbase = (u.pm * BM < split) ? xA + (size_t)row0 * 2048 : xB + (size_t)(row0 - split) * 2048;
#pragma unroll
        for (int ai = 0; ai < 2; ++ai)
#pragma unroll
            for (int m = 0; m < 4; ++m) { const int r = row0 + ai * HALF + m * 16;
                float mu = 0.f, rs = 1.f;
                if (stat_old) { const f32x2 st = *(const f32x2*)(stat_old + 2 * (size_t)r); mu = st.x * (1.0f / 2048.0f); rs = __builtin_amdgcn_rsqf(st.y * (1.0f / 2048.0f) - mu * mu + 1e-5f); }
                float a = 0.f, q = 0.f;
#pragma unroll
                for (int bj = 0; bj < 2; ++bj) { const size_t off = (size_t)r * 2048 + col0 + bj * HALF;
                    f32x4 res[2];
                    if (stat_old) {
#pragma unroll
                        for (int n = 0; n < 2; ++n) { const f32x4 gg = *(const f32x4*)(g + col0 + bj * HALF + 4 * n), bb = *(const f32x4*)(b + col0 + bj * HALF + 4 * n); const f32x4 yo = *(const f32x4*)(Y + off + 4 * n); res[n] = (yo - mu) * rs * gg + bb; } }
                    else {
#pragma unroll
                        for (int n = 0; n < 2; ++n) res[n] = *(const f32x4*)(xbase + (size_t)(ai * HALF + m * 16) * 2048 + col0 + bj * HALF + 4 * n); }
                    f32x4 yn[2];
#pragma unroll
                    for (int n = 0; n < 2; ++n) { yn[n] = res[n] * alpha + acc[ai][bj][m][n] * s; *(f32x4*)(Y + off + 4 * n) = yn[n];
                        a += (yn[n][0] + yn[n][1]) + (yn[n][2] + yn[n][3]); q += (yn[n][0] * yn[n][0] + yn[n][1] * yn[n][1]) + (yn[n][2] * yn[n][2] + yn[n][3] * yn[n][3]); }
                    u32x4 w; w.x = cvt_pk_bf16(yn[0][0], yn[0][1]); w.y = cvt_pk_bf16(yn[0][2], yn[0][3]); w.z = cvt_pk_bf16(yn[1][0], yn[1][1]); w.w = cvt_pk_bf16(yn[1][2], yn[1][3]);
                    *(u32x4*)(YB + off) = w; }
                a += __shfl_xor(a, 16); a += __shfl_xor(a, 32); q += __shfl_xor(q, 16); q += __shfl_xor(q, 32);
                if (fq == 0) { float* sp = stat_new + 2 * (size_t)r;
                    __hip_atomic_fetch_add(sp, a, __ATOMIC_RELAXED, __HIP_MEMORY_SCOPE_AGENT); __hip_atomic_fetch_add(sp + 1, q, __ATOMIC_RELAXED, __HIP_MEMORY_SCOPE_AGENT); }
                asm volatile("" ::: "memory"); }
    }
};
struct EpiUqka {
    static constexpr bool PERM = true;
    bf16_t* HQ; float* ALO; LnFold L;
    __device__ __forceinline__ void operator()(const f32x4 (&acc)[2][2][4][2], const Unit& u, int wr, int wc, int fr, int fq) const {
        const int row0 = u.pm * BM + wr * 64 + fr, col0 = u.pn * BM + wc * 32 + 8 * fq;
        const float sc = (u.pn >= 4 && u.pn < 8) ? 0.0625f : 1.0f;
#pragma unroll
        for (int bj = 0; bj < 2; ++bj) {
            f32x4 k1[2], k2[2];
#pragma unroll
            for (int n = 0; n < 2; ++n) { k1[n] = *(const f32x4*)(L.c1 + col0 + bj * HALF + 4 * n); k2[n] = *(const f32x4*)(L.c2 + col0 + bj * HALF + 4 * n); }
#pragma unroll
            for (int ai = 0; ai < 2; ++ai)
#pragma unroll
                for (int m = 0; m < 4; ++m) { const int r = row0 + ai * HALF + m * 16; float mu, rs; L.row_stats(r, mu, rs);
                    f32x4 v[2];
#pragma unroll
                    for (int n = 0; n < 2; ++n) v[n] = ((acc[ai][bj][m][n] - k1[n] * mu) * rs + k2[n]) * sc;
                    if (u.pn < 12) { u32x4 w; w.x = cvt_pk_bf16(v[0][0], v[0][1]); w.y = cvt_pk_bf16(v[0][2], v[0][3]); w.z = cvt_pk_bf16(v[1][0], v[1][1]); w.w = cvt_pk_bf16(v[1][2], v[1][3]);
                        *(u32x4*)(HQ + (size_t)r * 3072 + col0 + bj * HALF) = w; }
                    else if (bj == 0 && wc == 0 && fq < 2) { float* rowp = ALO + (size_t)r * 16 + 8 * fq; *(f32x4*)rowp = v[0]; *(f32x4*)(rowp + 4) = v[1]; } }
        }
    }
};
struct EpiRgg {
    static constexpr bool PERM = true;
    bf16_t* HR; LnFold L;
    __device__ __forceinline__ void operator()(const f32x4 (&acc)[2][2][4][2], const Unit& u, int wr, int wc, int fr, int fq) const {
        const int row0 = u.pm * BM + wr * 64 + fr, col0 = u.pn * BM + wc * 32 + 8 * fq; const bool is_r = u.pn < 8;
#pragma unroll
        for (int bj = 0; bj < 2; ++bj) {
            f32x4 k1[2], k2[2];
#pragma unroll
            for (int n = 0; n < 2; ++n) { k1[n] = *(const f32x4*)(L.c1 + col0 + bj * HALF + 4 * n); k2[n] = *(const f32x4*)(L.c2 + col0 + bj * HALF + 4 * n); }
#pragma unroll
            for (int ai = 0; ai < 2; ++ai)
#pragma unroll
                for (int m = 0; m < 4; ++m) { const int r = row0 + ai * HALF + m * 16; float mu, rs; L.row_stats(r, mu, rs);
                    float o[8];
#pragma unroll
                    for (int n = 0; n < 2; ++n)
#pragma unroll
                        for (int e = 0; e < 4; ++e) { const float x = rs * (acc[ai][bj][m][n][e] - mu * k1[n][e]) + k2[n][e], sg = sigmoidf_(x); o[4 * n + e] = is_r ? x * sg : sg; }
                    u32x4 w; w.x = cvt_pk_bf16(o[0], o[1]); w.y = cvt_pk_bf16(o[2], o[3]); w.z = cvt_pk_bf16(o[4], o[5]); w.w = cvt_pk_bf16(o[6], o[7]);
                    *(u32x4*)(HR + (size_t)r * 6144 + col0 + bj * HALF) = w; }
        }
    }
};
struct EpiPool {
    static constexpr bool PERM = true;
    bf16_t* YA; const bf16_t* HR; const float* ps;
    __device__ __forceinline__ void operator()(const f32x4 (&acc)[2][2][4][2], const Unit& u, int wr, int wc, int fr, int fq) const {
        const int row0 = u.pm * BM + wr * 64 + fr, col0 = u.pn * BM + wc * 32 + 8 * fq;
#pragma unroll
        for (int bj = 0; bj < 2; ++bj) { const f32x4 pv0 = *(const f32x4*)(ps + col0 + bj * HALF), pv1 = *(const f32x4*)(ps + col0 + bj * HALF + 4);
#pragma unroll
        for (int ai = 0; ai < 2; ++ai)
#pragma unroll
            for (int m = 0; m < 4; ++m) { const size_t r = (size_t)(row0 + ai * HALF + m * 16);
                { const u32x4 g = *(const u32x4*)(HR + r * 6144 + 2048 + col0 + bj * HALF);
                    const f32x4 v0 = acc[ai][bj][m][0] * pv0, v1 = acc[ai][bj][m][1] * pv1;
                    u32x4 w; w.x = cvt_pk_bf16(v0[0] * bf_lo(g.x), v0[1] * bf_hi(g.x)); w.y = cvt_pk_bf16(v0[2] * bf_lo(g.y), v0[3] * bf_hi(g.y));
                    w.z = cvt_pk_bf16(v1[0] * bf_lo(g.z), v1[1] * bf_hi(g.z)); w.w = cvt_pk_bf16(v1[2] * bf_lo(g.w), v1[3] * bf_hi(g.w));
                    *(u32x4*)(YA + r * 2048 + col0 + bj * HALF) = w; }
                if (m & 1) asm volatile("" ::: "memory"); } }
    }
};
struct EpiMerge {
    static constexpr bool PERM = true;
    bf16_t* MG; const bf16_t* YA; const bf16_t* HR;
    __device__ __forceinline__ void operator()(const f32x4 (&acc)[2][2][4][2], const Unit& u, int wr, int wc, int fr, int fq) const {
        const int row0 = u.pm * BM + wr * 64 + fr, col0 = u.pn * BM + wc * 32 + 8 * fq;
#pragma unroll
        for (int ai = 0; ai < 2; ++ai)
#pragma unroll
            for (int m = 0; m < 4; ++m) { const size_t r = (size_t)(row0 + ai * HALF + m * 16);
#pragma unroll
                for (int bj = 0; bj < 2; ++bj) { const u32x4 g = *(const u32x4*)(HR + r * 6144 + 4096 + col0 + bj * HALF); const u32x4 y = *(const u32x4*)(YA + r * 2048 + col0 + bj * HALF);
                    const f32x4 v0 = acc[ai][bj][m][0], v1 = acc[ai][bj][m][1];
                    u32x4 w; w.x = cvt_pk_bf16(bf_lo(y.x) + v0[0] * bf_lo(g.x), bf_hi(y.x) + v0[1] * bf_hi(g.x)); w.y = cvt_pk_bf16(bf_lo(y.y) + v0[2] * bf_lo(g.y), bf_hi(y.y) + v0[3] * bf_hi(g.y));
                    w.z = cvt_pk_bf16(bf_lo(y.z) + v1[0] * bf_lo(g.z), bf_hi(y.z) + v1[1] * bf_hi(g.z)); w.w = cvt_pk_bf16(bf_lo(y.w) + v1[2] * bf_lo(g.w), bf_hi(y.w) + v1[3] * bf_hi(g.w));
                    *(u32x4*)(MG + r * 2048 + col0 + bj * HALF) = w; }
                asm volatile("" ::: "memory"); }
    }
};

template <class Epi, class Sched, bool ALIGN_EPI = true, bool SP2 = true>
__device__ __forceinline__ void gemm_phase(PG8_LAS unsigned char* lds, const Gemm g, const Sched& S, const Epi& E) {
    int tid_ = threadIdx.x; asm volatile("" : "+v"(tid_));
    const int tid = tid_, wid = __builtin_amdgcn_readfirstlane(tid >> 6), lane = tid & 63, wr = wid >> 2, wc = wid & 3, fr = lane & 15, fq = lane >> 4;
    const int K = g.K, nt = K / BK;
    unsigned voffA[2], voffB[2];
#pragma unroll
    for (int i = 0; i < 2; ++i) { int R, C; stage_rc(tid * 16 + i * 8192, R, C); const int Rb = Epi::PERM ? ((R & ~31) + perm32(R & 31)) : R;
        voffA[i] = (unsigned)(R * g.lda + C) * 2u; voffB[i] = (unsigned)(Rb * g.ldb + C) * 2u; }
    const size_t kstep = (size_t)(BK * 2);
    const size_t hstepA = (size_t)HALF * g.lda * 2, hstepB = (size_t)HALF * g.ldb * 2;
    const size_t tstepA = 2 * hstepA, tstepB = 2 * hstepB;
    const unsigned ldsw = (unsigned)wid * 1024u;
    const int aoff = lds_byte(wr * 64 + fr, fq * 8), boff = lds_byte(wc * 32 + fr, fq * 8);
#define PG8_SA(b, h) (((b) * 2 + (h)) * HTB)
#define PG8_SB(b, h) ((4 + (b) * 2 + (h)) * HTB)
#define PG8_STAGE(bufoff, gbase, voff) do { _Pragma("unroll") for (int _i = 0; _i < 2; ++_i) \
        __builtin_amdgcn_global_load_lds((const unsigned*)((const char*)(gbase) + (voff)[_i]), (PG8_LAS unsigned*)(lds + (bufoff) + ldsw + _i * 8192), 16, 0, 0); } while (0)
#define PG8_LDA(dst, b, h) do { _Pragma("unroll") for (int m = 0; m < 4; ++m) _Pragma("unroll") for (int k = 0; k < 2; ++k) dst[m][k] = *(const PG8_LAS bf16x8*)(lds + PG8_SA(b, h) + aoff + m * 2048 + k * 1024); } while (0)
#define PG8_LDB(dst, b, h) do { _Pragma("unroll") for (int n = 0; n < 2; ++n) _Pragma("unroll") for (int k = 0; k < 2; ++k) dst[n][k] = *(const PG8_LAS bf16x8*)(lds + PG8_SB(b, h) + boff + n * 2048 + k * 1024); } while (0)
#define PG8_MMA(ai, bj, At, Bt) do { __builtin_amdgcn_s_setprio(1); _Pragma("unroll") for (int m = 0; m < 4; ++m) _Pragma("unroll") for (int n = 0; n < 2; ++n) _Pragma("unroll") for (int k = 0; k < 2; ++k) \
        acc[ai][bj][m][n] = __builtin_amdgcn_mfma_f32_16x16x32_bf16(Bt[n][k], At[m][k], acc[ai][bj][m][n], 0, 0, 0); __builtin_amdgcn_s_setprio(0); } while (0)
#define PG8_WAIT_V(n) asm volatile("s_waitcnt vmcnt(" #n ")" ::: "memory")
#define PG8_WAIT_L(n) asm volatile("s_waitcnt lgkmcnt(" #n ")" ::: "memory")
#define PG8_BAR __builtin_amdgcn_s_barrier()
#define PG8_SCHED __builtin_amdgcn_sched_barrier(0)
#define PG8_APTR(u) ((const char*)g.A + (size_t)(u).pm * tstepA + (size_t)(((u).pn >> g.a_shift) * g.a_mul) * 2)
#define PG8_BPTR(u) ((const char*)g.Bt + (size_t)(u).pn * tstepB)
    Unit cur, nxt; int ui = 0;
    if (!S.next(0, cur)) return;
    f32x4 acc[2][2][4][2];
#pragma unroll
    for (int a = 0; a < 2; ++a)
#pragma unroll
        for (int b = 0; b < 2; ++b)
#pragma unroll
            for (int m = 0; m < 4; ++m)
#pragma unroll
                for (int n = 0; n < 2; ++n) acc[a][b][m][n] = (f32x4){0.f, 0.f, 0.f, 0.f};
    bf16x8 At[4][2], B0[2][2], B1[2][2];
    const char* cA = PG8_APTR(cur); const char* cB = PG8_BPTR(cur);
    S.a_ready(cur);
    if constexpr (SP2) {
        PG8_STAGE(PG8_SB(0, 0), cB, voffB); PG8_STAGE(PG8_SB(0, 1), cB + hstepB, voffB); PG8_STAGE(PG8_SA(0, 0), cA, voffA); PG8_STAGE(PG8_SA(0, 1), cA + hstepA, voffA);
        if (wr == 1) PG8_BAR;
        PG8_WAIT_V(2); PG8_BAR;
        PG8_STAGE(PG8_SB(1, 0), cB + kstep, voffB); PG8_STAGE(PG8_SA(1, 0), cA + kstep, voffA); PG8_STAGE(PG8_SB(1, 1), cB + hstepB + kstep, voffB);
        PG8_WAIT_V(6); PG8_BAR;
    } else {
        PG8_STAGE(PG8_SB(0, 0), cB, voffB); PG8_STAGE(PG8_SA(0, 0), cA, voffA); PG8_STAGE(PG8_SB(0, 1), cB + hstepB, voffB); PG8_STAGE(PG8_SA(0, 1), cA + hstepA, voffA);
        if (wr == 1) PG8_BAR;
        PG8_WAIT_V(4); PG8_BAR;
        PG8_STAGE(PG8_SB(1, 0), cB + kstep, voffB); PG8_STAGE(PG8_SA(1, 0), cA + kstep, voffA); PG8_STAGE(PG8_SB(1, 1), cB + hstepB + kstep, voffB);
        PG8_WAIT_V(6); PG8_BAR;
    }
    for (;;) {
        const bool has_next = S.next(ui + 1, nxt);
        const char* nA = has_next ? PG8_APTR(nxt) : cA; const char* nB = has_next ? PG8_BPTR(nxt) : cB;
        for (int t = 0; t < nt; t += 2) {
            const bool last = (t == nt - 2);
            const char* a1 = cA + (size_t)(t + 1) * kstep;
            const char* a2 = last ? nA : cA + (size_t)(t + 2) * kstep; const char* b2 = last ? nB : cB + (size_t)(t + 2) * kstep;
            const char* a3 = a2 + kstep; const char* b3 = b2 + kstep;
            if (last && has_next) S.a_ready(nxt);
            if constexpr (SP2) {
            PG8_LDB(B0, 0, 0); PG8_LDB(B1, 0, 1); PG8_SCHED; PG8_LDA(At, 0, 0); PG8_STAGE(PG8_SA(1, 1), a1 + hstepA, voffA);
            PG8_WAIT_V(8); PG8_WAIT_L(0); PG8_BAR; PG8_MMA(0, 0, At, B0); PG8_MMA(0, 1, At, B1); PG8_BAR; PG8_SCHED;
            PG8_LDA(At, 0, 1); PG8_STAGE(PG8_SB(0, 0), b2, voffB); PG8_STAGE(PG8_SB(0, 1), b2 + hstepB, voffB); PG8_STAGE(PG8_SA(0, 0), a2, voffA);
            PG8_WAIT_V(8); PG8_WAIT_L(0); PG8_BAR; PG8_MMA(1, 0, At, B0); PG8_MMA(1, 1, At, B1); PG8_BAR; PG8_SCHED;
            PG8_LDB(B0, 1, 0); PG8_LDB(B1, 1, 1); PG8_SCHED; PG8_LDA(At, 1, 0); PG8_STAGE(PG8_SA(0, 1), a2 + hstepA, voffA);
            PG8_WAIT_V(8); PG8_WAIT_L(0); PG8_BAR; PG8_MMA(0, 0, At, B0); PG8_MMA(0, 1, At, B1); PG8_BAR; PG8_SCHED;
            PG8_LDA(At, 1, 1); PG8_STAGE(PG8_SB(1, 0), b3, voffB); PG8_STAGE(PG8_SB(1, 1), b3 + hstepB, voffB); PG8_STAGE(PG8_SA(1, 0), a3, voffA);
            PG8_WAIT_V(8); PG8_WAIT_L(0); PG8_BAR; PG8_MMA(1, 0, At, B0); PG8_MMA(1, 1, At, B1); PG8_BAR; PG8_SCHED;
            } else {
            PG8_LDB(B0, 0, 0); PG8_SCHED; PG8_LDA(At, 0, 0); PG8_STAGE(PG8_SA(1, 1), a1 + hstepA, voffA);
            PG8_WAIT_L(8); PG8_BAR; PG8_WAIT_L(0); PG8_MMA(0, 0, At, B0); PG8_BAR; PG8_SCHED;
            PG8_LDB(B1, 0, 1); PG8_STAGE(PG8_SB(0, 0), b2, voffB);
            PG8_BAR; PG8_WAIT_L(0); PG8_MMA(0, 1, At, B1); PG8_BAR;
            PG8_LDA(At, 0, 1); PG8_STAGE(PG8_SA(0, 0), a2, voffA);
            PG8_BAR; PG8_WAIT_L(0); PG8_MMA(1, 0, At, B0); PG8_BAR; PG8_SCHED;
            PG8_STAGE(PG8_SB(0, 1), b2 + hstepB, voffB);
            PG8_WAIT_V(6); PG8_BAR; PG8_MMA(1, 1, At, B1); PG8_BAR;
            PG8_LDB(B0, 1, 0); PG8_SCHED; PG8_LDA(At, 1, 0); PG8_STAGE(PG8_SA(0, 1), a2 + hstepA, voffA);
            PG8_WAIT_L(8); PG8_BAR; PG8_WAIT_L(0); PG8_MMA(0, 0, At, B0); PG8_BAR; PG8_SCHED;
            PG8_LDB(B1, 1, 1); PG8_STAGE(PG8_SB(1, 0), b3, voffB);
            PG8_BAR; PG8_WAIT_L(0); PG8_MMA(0, 1, At, B1); PG8_BAR;
            PG8_LDA(At, 1, 1); PG8_STAGE(PG8_SA(1, 0), a3, voffA);
            PG8_BAR; PG8_WAIT_L(0); PG8_MMA(1, 0, At, B0); PG8_BAR; PG8_SCHED;
            PG8_STAGE(PG8_SB(1, 1), b3 + hstepB, voffB);
            PG8_WAIT_V(6); PG8_BAR; PG8_MMA(1, 1, At, B1); PG8_BAR;
            }
        }
        if constexpr (ALIGN_EPI) { if (wr == 0) PG8_BAR; }
        E(acc, cur, wr, wc, fr, fq); S.done(cur);
        if (!has_next) break;
#pragma unroll
        for (int a = 0; a < 2; ++a)
#pragma unroll
            for (int b = 0; b < 2; ++b)
#pragma unroll
                for (int m = 0; m < 4; ++m)
#pragma unroll
                    for (int n = 0; n < 2; ++n) acc[a][b][m][n] = (f32x4){0.f, 0.f, 0.f, 0.f};
        cur = nxt; cA = nA; cB = nB; ++ui;
        if constexpr (ALIGN_EPI) { if (wr == 1) PG8_BAR; }
    }
    PG8_WAIT_V(0);
    if constexpr (!ALIGN_EPI) { if (wr == 0) PG8_BAR; }
    PG8_BAR;
#undef PG8_SA
#undef PG8_SB
#undef PG8_STAGE
#undef PG8_LDA
#undef PG8_LDB
#undef PG8_MMA
#undef PG8_WAIT_V
#undef PG8_WAIT_L
#undef PG8_BAR
#undef PG8_SCHED
#undef PG8_APTR
#undef PG8_BPTR
}
}

constexpr int NWAVES = 8;
constexpr int D = 2048, MP = 8192, MS = 1024, M = MP + MS;
constexpr int SEQ = 2048, NB = 4, DECB = 128, DECT = 8;
constexpr int FF = 5632, FF2 = 2 * FF, INW = 11280;
constexpr int PW = 1024, PBUF = 15;
constexpr int GH = 4, DK = 256, DV = 512, GK = 1024, GV = 2048, RANK = 16;
constexpr float LN_EPS = 1e-5f, HN_EPS = 1e-6f;
constexpr float ALPHA = 1.41421356237309515f;
constexpr int NCHUNK = 256;

constexpr size_t O_Y = 0, O_NPP = (size_t)M * D, O_NGP = O_NPP + (size_t)2 * NB * PBUF * PW, O_NPS = O_NGP + (size_t)2 * NB * GH * DK * DV,
                 O_NGS = O_NPS + (size_t)2 * DECB * PBUF * PW, O_END = O_NGS + (size_t)2 * DECB * GH * DK * DV;

constexpr size_t MiB = 1u << 20;
constexpr size_t WS_CTL = 0, CTL_ZERO_BYTES = 2 * MiB;
constexpr size_t WS_STAT = 128 * 1024, SZ_STAT = (size_t)M * 2 * 4;
constexpr size_t WS_CFI = 576 * 1024, SZ_CFI = (size_t)FF2 * 4;
constexpr size_t WS_CMIX = WS_CFI + 8 * SZ_CFI, SZ_CMIX = (size_t)(3328 + 6144 + 2048) * 4;
constexpr size_t WS_ZERO = WS_CMIX + 4 * SZ_CMIX;
static_assert(WS_STAT + 6 * SZ_STAT <= WS_CFI && WS_ZERO + SZ_CFI <= CTL_ZERO_BYTES, "zeroed region");
constexpr size_t SZ_WFI = (size_t)FF2 * D * 2, SZ_WFO = (size_t)D * FF * 2, SZ_WUQKA = (size_t)3328 * D * 2, SZ_WV = (size_t)D * D * 2, SZ_WRGG = (size_t)6144 * D * 2,
                 SZ_WPOOL = (size_t)2048 * 256 * 2, SZ_WSQ = (size_t)D * D * 2;
constexpr size_t WS_WFI = 2 * MiB;
constexpr size_t WS_WFO = WS_WFI + 4 * SZ_WFI;
constexpr size_t WS_WUQKA = WS_WFO + 4 * SZ_WFO;
constexpr size_t WS_WV = WS_WUQKA + 2 * SZ_WUQKA;
constexpr size_t WS_WRGG = WS_WV + 2 * SZ_WV;
constexpr size_t WS_WPOOL = WS_WRGG + 2 * SZ_WRGG;
constexpr size_t WS_WGO = WS_WPOOL + 2 * SZ_WPOOL;
constexpr size_t WS_WO = WS_WGO + 2 * SZ_WSQ;
constexpr size_t WS_XB = WS_WO + 2 * SZ_WSQ;
constexpr size_t WS_YB = WS_XB + (size_t)M * D * 2;
constexpr size_t WS_Y = WS_YB + (size_t)M * D * 2;
constexpr size_t WS_ACT = WS_Y + (size_t)M * D * 4;
constexpr size_t WS_HQ = WS_ACT + (size_t)M * FF * 2;
constexpr size_t WS_HR = WS_HQ + (size_t)M * 3072 * 2;
constexpr size_t WS_VT = WS_HR + (size_t)M * 6144 * 2;
constexpr size_t WS_ALO = WS_VT + (size_t)M * D * 2;
constexpr size_t WS_POOLED = WS_ALO + 1 * MiB;
constexpr size_t WS_QT = WS_POOLED + (size_t)M * 1024 * 2;
constexpr size_t WS_KT = WS_QT + (size_t)M * 1024 * 2;
constexpr size_t WS_KHT = WS_KT + (size_t)M * 1024 * 2;
constexpr size_t WS_GDEC = WS_KHT + (size_t)M * 1024 * 2;
constexpr size_t WS_ORAW = WS_GDEC + 1 * MiB;
constexpr size_t WS_OG = WS_ORAW + (size_t)M * D * 4;
constexpr size_t WS_YA = WS_OG + (size_t)M * D * 2;
constexpr size_t WS_MG = WS_YA + (size_t)M * D * 2;
constexpr size_t WS_END = WS_MG + (size_t)M * D * 2;
constexpr int CW_BAR = 4096;
constexpr int CW_QUEUE = 16384;

constexpr int RING_BYTES = 135168;
constexpr int LDSCTL_OFF = RING_BYTES, MISC_OFF = LDSCTL_OFF + 320;
constexpr int LDS_BYTES = 147456;

#define GAS __attribute__((address_space(1)))
#define LAS __attribute__((address_space(3)))
typedef unsigned short bf16;
typedef unsigned v4u __attribute__((ext_vector_type(4)));
typedef unsigned v2u __attribute__((ext_vector_type(2)));
typedef float f32x4 __attribute__((ext_vector_type(4)));
typedef float f32x2 __attribute__((ext_vector_type(2)));
typedef short bf16x8 __attribute__((ext_vector_type(8)));
typedef short bf16x4 __attribute__((ext_vector_type(4)));
typedef GAS unsigned gu32;
#define RLX_AGENT __ATOMIC_RELAXED, __HIP_MEMORY_SCOPE_AGENT
#define LDS_WAIT() asm volatile("s_waitcnt lgkmcnt(0)" ::: "memory")
#define VM_WAIT() asm volatile("s_waitcnt vmcnt(0)" ::: "memory")
__device__ __forceinline__ unsigned f2bf(float f) { unsigned u = __builtin_bit_cast(unsigned, f); return (u + 0x7fffu + ((u >> 16) & 1u)) >> 16; }
__device__ __forceinline__ unsigned pk2(float lo, float hi) { return pg8::cvt_pk_bf16(lo, hi); }
__device__ __forceinline__ float bf2f(bf16 b) { return __uint_as_float(((unsigned)b) << 16); }

#define XB_TMO      128
#define XB_XCNT(j)  (256  + 64 * (j))
#define XB_XSUB(j)  (1280 + 64 * (j))
#define XB_XGEN(j)  (2304 + 64 * (j))
#define XB_TOP      3328
#define XB_TOPGEN   3392
#define XCD_BAR_WORDS 3456
#define XB_SPIN_CAP (1u << 20)

__device__ __forceinline__ unsigned xb_ld(unsigned* p)              { return __hip_atomic_load(p, __ATOMIC_RELAXED, __HIP_MEMORY_SCOPE_AGENT); }
__device__ __forceinline__ unsigned xb_add(unsigned* p, unsigned v) { return __hip_atomic_fetch_add(p, v, __ATOMIC_RELAXED, __HIP_MEMORY_SCOPE_AGENT); }
__device__ __forceinline__ unsigned xb_xcc_id() { return (unsigned)__builtin_amdgcn_s_getreg((3 << 11) | 20) & 0xFu; }
#define XB_SPIN(cond, bar) do { unsigned _sp = 0; while (cond) { __builtin_amdgcn_s_sleep(1); \
    if ((++_sp & 255u) == 0u) { if (xb_ld(&(bar)[XB_TMO])) break; if (_sp > XB_SPIN_CAP) { atomicAdd(&(bar)[XB_TMO], 1u); break; } } } } while (0)

struct XcdBarrier { unsigned* bar; unsigned x; volatile LAS unsigned* st; };

__device__ __forceinline__ XcdBarrier xcd_barrier_post(unsigned* bar, volatile LAS unsigned* st) {
    XcdBarrier b; b.bar = bar; b.x = xb_xcc_id(); b.st = st;
    if (threadIdx.x == 0) (void)xb_add(&bar[XB_XCNT(b.x)], 1u);
    return b;
}
__device__ __forceinline__ void xcd_barrier_complete(unsigned* bar, unsigned x, unsigned& nloc, unsigned& nx) {
    const unsigned G = gridDim.x * gridDim.y * gridDim.z;
    unsigned sum, cnt, mine, sp = 0u;
    for (;;) {
        sum = 0u; cnt = 0u; mine = 0u;
#pragma unroll
        for (unsigned j = 0; j < 16; ++j) { const unsigned c = xb_ld(&bar[XB_XCNT(j)]); sum += c; cnt += (c > 0u) ? 1u : 0u; mine = (j == x) ? c : mine; }
        if (sum == G) break;
        __builtin_amdgcn_s_sleep(1);
        if ((++sp & 255u) == 0u) { if (xb_ld(&bar[XB_TMO])) break; if (sp > XB_SPIN_CAP) { atomicAdd(&bar[XB_TMO], 1u); break; } }
    }
    nloc = mine > 0u ? mine : 1u; nx = cnt > 0u ? cnt : 1u;
}
__device__ __forceinline__ void xcd_barrier(const XcdBarrier& b) {
    asm volatile("s_waitcnt vmcnt(0)" ::: "memory");
    __syncthreads();
    if (threadIdx.x == 0) {
        unsigned* bar = b.bar;
        __builtin_amdgcn_s_waitcnt(0);
        unsigned nloc = b.st[0], nx = b.st[1];
        if (nloc == 0u) { xcd_barrier_complete(bar, b.x, nloc, nx); b.st[0] = nloc; b.st[1] = nx; }
        const unsigned old = xb_add(&bar[XB_XSUB(b.x)], 1u);
        const unsigned gen = old / nloc;
        if (old + 1u == (gen + 1u) * nloc) {
            __builtin_amdgcn_fence(__ATOMIC_RELEASE, "agent");
            asm volatile("s_waitcnt vmcnt(0)" ::: "memory");
            const unsigned og = xb_add(&bar[XB_TOP], 1u);
            const unsigned tg = og / nx;
            if (og + 1u == (tg + 1u) * nx) xb_add(&bar[XB_TOPGEN], 1u);
            else XB_SPIN(xb_ld(&bar[XB_TOPGEN]) == tg, bar);
            __builtin_amdgcn_fence(__ATOMIC_ACQUIRE, "agent");
            xb_add(&bar[XB_XGEN(b.x)], 1u);
            asm volatile("s_waitcnt vmcnt(0)" ::: "memory");
        } else {
            XB_SPIN(xb_ld(&bar[XB_XGEN(b.x)]) == gen, bar);
            __builtin_amdgcn_fence(__ATOMIC_ACQUIRE, "agent");
            asm volatile("s_waitcnt vmcnt(0)" ::: "memory");
        }
    }
    __syncthreads();
}

struct Args { const float* in[16]; float* out; unsigned char* ws; int ph_lo, ph_hi; };
extern __shared__ __attribute__((aligned(16))) unsigned char lds_raw[];
constexpr int TAB_OFF = LDSCTL_OFF + 64;
#define LDSB ((LAS unsigned char*)lds_raw)
__device__ __forceinline__ GAS unsigned char* tab_ptr(int i) {
    volatile LAS unsigned* t = (volatile LAS unsigned*)(LDSB + TAB_OFF) + 2 * i;
    const unsigned lo = __builtin_amdgcn_readfirstlane(t[0]), hi = __builtin_amdgcn_readfirstlane(t[1]);
    return (GAS unsigned char*)(((unsigned long long)hi << 32) | lo);
}
#define TP(T, i) ((T*)tab_ptr(i))
#define TID ((int)threadIdx.x)
#define LANE ((int)(threadIdx.x & 63))
#define WAVE (__builtin_amdgcn_readfirstlane((int)(threadIdx.x >> 6)))
#define GRID ((int)gridDim.x)
#define BID ((int)blockIdx.x)
struct Frame {};
__device__ __forceinline__ int opaque_tid() { int t = threadIdx.x; asm volatile("" : "+v"(t)); return t; }
#define PHASE_IDS const int tid_o = opaque_tid(), lane_o = tid_o & 63, wave_o = __builtin_amdgcn_readfirstlane(tid_o >> 6)
__device__ __forceinline__ float wave_sum(float v) {
#pragma unroll
    for (int o = 1; o < 64; o <<= 1) v += __shfl_xor(v, o);
    return v;
}

__device__ __forceinline__ void transpose_item(const float* W, int ldw, int k0, int n0, bf16* WT, int ldd, int dst_row0, LAS float* scr, int lane, const float* g, const float* b, float* c1, float* c2) {
#pragma unroll 8
    for (int i = 0; i < 32; ++i) { const int kk = 2 * i + (lane >> 5); scr[kk * 33 + (lane & 31)] = W[(size_t)(k0 + kk) * ldw + n0 + (lane & 31)]; }
    LDS_WAIT(); asm volatile("" ::: "memory");
    const int c = lane & 7;
    float gk[8], bk[8];
    if (g) {
#pragma unroll
        for (int e = 0; e < 8; ++e) { gk[e] = g[k0 + 8 * c + e]; bk[e] = b[k0 + 8 * c + e]; } }
#pragma unroll
    for (int j = 0; j < 4; ++j) { const int n = (lane >> 3) + 8 * j; const LAS float* s = scr + (8 * c) * 33 + n;
        float wv[8];
#pragma unroll
        for (int e = 0; e < 8; ++e) wv[e] = s[e * 33];
        v4u o;
        if (g) {
            float p2 = 0.f;
#pragma unroll
            for (int e = 0; e < 8; ++e) { p2 += bk[e] * wv[e]; wv[e] *= gk[e]; }
            o.x = pk2(wv[0], wv[1]); o.y = pk2(wv[2], wv[3]); o.z = pk2(wv[4], wv[5]); o.w = pk2(wv[6], wv[7]);
            float p1 = ((pg8::bf_lo(o.x) + pg8::bf_hi(o.x)) + (pg8::bf_lo(o.y) + pg8::bf_hi(o.y))) + ((pg8::bf_lo(o.z) + pg8::bf_hi(o.z)) + (pg8::bf_lo(o.w) + pg8::bf_hi(o.w)));
            p1 += __shfl_xor(p1, 1); p1 += __shfl_xor(p1, 2); p1 += __shfl_xor(p1, 4); p2 += __shfl_xor(p2, 1); p2 += __shfl_xor(p2, 2); p2 += __shfl_xor(p2, 4);
            if (c == 0) { __hip_atomic_fetch_add(c1 + dst_row0 + n, p1, __ATOMIC_RELAXED, __HIP_MEMORY_SCOPE_AGENT); __hip_atomic_fetch_add(c2 + dst_row0 + n, p2, __ATOMIC_RELAXED, __HIP_MEMORY_SCOPE_AGENT); }
        } else { o.x = pk2(wv[0], wv[1]); o.y = pk2(wv[2], wv[3]); o.z = pk2(wv[4], wv[5]); o.w = pk2(wv[6], wv[7]); }
        *(GAS v4u*)(WT + (size_t)(dst_row0 + n) * ldd + k0 + 8 * c) = o; }
    LDS_WAIT(); asm volatile("" ::: "memory");
}
constexpr int IT_FI = (D / 64) * (FF2 / 32);
constexpr int IT_FO = (FF / 64) * (D / 32);
constexpr int IT_UQK = (D / 64) * (3072 / 32);
constexpr int IT_ALO = (D / 64);
constexpr int IT_V = (D / 64) * (2048 / 32);
constexpr int IT_RGG = (D / 64) * (6144 / 32);
constexpr int IT_POOL = 4 * (256 / 64) * (512 / 32);
constexpr int IT_SQ = (D / 64) * (D / 32);
constexpr int IT_LAYER = 2 * IT_FI + 2 * IT_FO + IT_UQK + IT_ALO + IT_V + IT_RGG + IT_POOL + 2 * IT_SQ;

__device__ __forceinline__ void p0_prologue(Frame& F) {
    PHASE_IDS;
    unsigned char* const ws = TP(unsigned char, 17);
    LAS float* scr = (LAS float*)(LDSB + wave_o * 16384);
    const int gw = BID * NWAVES + wave_o, NGW = GRID * NWAVES;
    const float* w_ffn_in = TP(const float, 6); const float* w_ffn_out = TP(const float, 7); const float* w_in = TP(const float, 8); const float* pool_w = TP(const float, 9);
    const float* w_gla_out = TP(const float, 14); const float* w_out = TP(const float, 15);
    const float* ln_g = TP(const float, 4); const float* ln_b = TP(const float, 5);
    for (int it = gw; it < 2 * IT_LAYER; it += NGW) {
        const int l = it / IT_LAYER; int r = it % IT_LAYER;
        if (r < 2 * IT_FI) { const int f = r / IT_FI; r %= IT_FI; const int nblk = FF2 / 32, kb = r / nblk, nb = r % nblk, n0 = 32 * nb, seg = n0 / FF, c = n0 % FF;
            const int lnidx = (f == 1) ? (l * 3 + 1) : ((l - 1) * 3 + 2); const bool fold = !(l == 0 && f == 0);
            float* cc = (float*)(ws + WS_CFI + (size_t)(l * 2 + f) * 2 * SZ_CFI);
            transpose_item(w_ffn_in + (size_t)(l * 2 + f) * D * FF2, FF2, 64 * kb, n0, (bf16*)(ws + WS_WFI + (size_t)(l * 2 + f) * SZ_WFI), D, 256 * (c / 128) + 128 * seg + (c % 128), scr, lane_o,
                           fold ? ln_g + (size_t)lnidx * D : nullptr, ln_b + (size_t)(fold ? lnidx : 0) * D, cc, cc + FF2); continue; }
        r -= 2 * IT_FI;
        if (r < 2 * IT_FO) { const int f = r / IT_FO; r %= IT_FO; const int nblk = D / 32, kb = r / nblk, nb = r % nblk;
            transpose_item(w_ffn_out + (size_t)(l * 2 + f) * FF * D, D, 64 * kb, 32 * nb, (bf16*)(ws + WS_WFO + (size_t)(l * 2 + f) * SZ_WFO), FF, 32 * nb, scr, lane_o, nullptr, nullptr, nullptr, nullptr); continue; }
        r -= 2 * IT_FO;
        const float* wi = w_in + (size_t)l * D * INW;
        const float* mg = ln_g + (size_t)(l * 3) * D; const float* mb = ln_b + (size_t)(l * 3) * D;
        float* cm1 = (float*)(ws + WS_CMIX + (size_t)l * 2 * SZ_CMIX); float* cm2 = cm1 + (3328 + 6144 + 2048);
        if (r < IT_UQK) { const int nblk = 3072 / 32, kb = r / nblk, nb = r % nblk;
            transpose_item(wi, INW, 64 * kb, 32 * nb, (bf16*)(ws + WS_WUQKA + (size_t)l * SZ_WUQKA), D, 32 * nb, scr, lane_o, mg, mb, cm1, cm2); continue; }
        r -= IT_UQK;
        if (r < IT_ALO) { transpose_item(wi, INW, 64 * r, 5120, (bf16*)(ws + WS_WUQKA + (size_t)l * SZ_WUQKA), D, 3072, scr, lane_o, mg, mb, cm1, cm2); continue; }
        r -= IT_ALO;
        if (r < IT_V) { const int nblk = 2048 / 32, kb = r / nblk, nb = r % nblk;
            transpose_item(wi, INW, 64 * kb, 3072 + 32 * nb, (bf16*)(ws + WS_WV + (size_t)l * SZ_WV), D, 32 * nb, scr, lane_o, mg, mb, cm1 + 3328 + 6144, cm2 + 3328 + 6144); continue; }
        r -= IT_V;
        if (r < IT_RGG) { const int nblk = 6144 / 32, kb = r / nblk, nb = r % nblk;
            transpose_item(wi, INW, 64 * kb, 5136 + 32 * nb, (bf16*)(ws + WS_WRGG + (size_t)l * SZ_WRGG), D, 32 * nb, scr, lane_o, mg, mb, cm1 + 3328, cm2 + 3328); continue; }
        r -= IT_RGG;
        if (r < IT_POOL) { const int g = r / 64, rr = r % 64, kb = rr / 16, nb = rr % 16;
            transpose_item(pool_w + (size_t)(l * 4 + g) * 256 * 512, 512, 64 * kb, 32 * nb, (bf16*)(ws + WS_WPOOL + (size_t)l * SZ_WPOOL), 256, g * 512 + 32 * nb, scr, lane_o, nullptr, nullptr, nullptr, nullptr); continue; }
        r -= IT_POOL;
        if (r < IT_SQ) { const int nblk = D / 32, kb = r / nblk, nb = r % nblk;
            transpose_item(w_gla_out + (size_t)l * D * D, D, 64 * kb, 32 * nb, (bf16*)(ws + WS_WGO + (size_t)l * SZ_WSQ), D, 32 * nb, scr, lane_o, nullptr, nullptr, nullptr, nullptr); continue; }
        r -= IT_SQ;
        { const int nblk = D / 32, kb = r / nblk, nb = r % nblk;
            transpose_item(w_out + (size_t)l * D * D, D, 64 * kb, 32 * nb, (bf16*)(ws + WS_WO + (size_t)l * SZ_WSQ), D, 32 * nb, scr, lane_o, nullptr, nullptr, nullptr, nullptr); }
    }
    for (int l = 0; l < 2; ++l) { GAS v4u* z = (GAS v4u*)(ws + WS_WUQKA + (size_t)l * SZ_WUQKA + (size_t)3104 * D * 2); const int n16 = (3328 - 3104) * D * 2 / 16;
        for (int i = gw * 64 + lane_o; i < n16; i += NGW * 64) z[i] = (v4u){0u, 0u, 0u, 0u}; }
    const float* xp = TP(const float, 0); const float* xs = TP(const float, 1); bf16* XB = (bf16*)(ws + WS_XB);
    for (int m = gw; m < M; m += NGW) { const float* src = m < MP ? xp + (size_t)m * D : xs + (size_t)(m - MP) * D;
        const GAS f32x4* xr = (const GAS f32x4*)src + lane_o; GAS v2u* o8 = (GAS v2u*)(XB + (size_t)m * D) + lane_o;
#pragma unroll
        for (int j = 0; j < 8; ++j) { const f32x4 v = xr[64 * j]; o8[64 * j] = (v2u){pk2(v.x, v.y), pk2(v.z, v.w)}; } }
}

__device__ __forceinline__ void ln_phase(Frame& F, const float* Y, const float* g, const float* b, float* outF, bf16* outB) {
    PHASE_IDS;
    const int gw = BID * NWAVES + wave_o, NGW = GRID * NWAVES;
    for (int m = gw; m < M; m += NGW) {
        const GAS f32x4* xr = (const GAS f32x4*)(Y + (size_t)m * D) + lane_o;
        f32x4 v[8]; float s = 0.f;
#pragma unroll
        for (int j = 0; j < 8; ++j) { v[j] = xr[64 * j]; s += (v[j].x + v[j].y) + (v[j].z + v[j].w); }
        const float mean = wave_sum(s) * (1.f / D); float s2 = 0.f;
#pragma unroll
        for (int j = 0; j < 8; ++j) { v[j] = v[j] - mean; s2 += (v[j].x * v[j].x + v[j].y * v[j].y) + (v[j].z * v[j].z + v[j].w * v[j].w); }
        const float rstd = 1.f / sqrtf(wave_sum(s2) * (1.f / D) + LN_EPS);
        GAS f32x4* of = (GAS f32x4*)(outF + (size_t)m * D) + lane_o;
#pragma unroll
        for (int j = 0; j < 8; ++j) { const f32x4 gg = *((const f32x4*)g + lane_o + 64 * j), bb = *((const f32x4*)b + lane_o + 64 * j);
            v[j] = v[j] * rstd * gg + bb; of[64 * j] = v[j]; }
        if (outB) { GAS v2u* o8 = (GAS v2u*)(outB + (size_t)m * D) + lane_o;
#pragma unroll
            for (int j = 0; j < 8; ++j) o8[64 * j] = (v2u){pk2(v[j].x, v[j].y), pk2(v[j].z, v[j].w)}; }
    }
}

__device__ __forceinline__ void prepass_phase(Frame& F, int l) {
    PHASE_IDS;
    unsigned char* const ws = TP(unsigned char, 17); float* const outp = TP(float, 16);
    LAS float* tile = (LAS float*)(LDSB + wave_o * 16640);
    const int gw = BID * NWAVES + wave_o, NGW = GRID * NWAVES, lane = lane_o;
    const bf16* HQ = (const bf16*)(ws + WS_HQ); const float* ALO = (const float*)(ws + WS_ALO);
    bf16* QT = (bf16*)(ws + WS_QT); bf16* KT = (bf16*)(ws + WS_KT); bf16* KHT = (bf16*)(ws + WS_KHT); bf16* PO = (bf16*)(ws + WS_POOLED); float* GD = (float*)(ws + WS_GDEC);
    const float* state_pool = TP(const float, 2) + (size_t)l * DECB * PBUF * PW; const float* a_up = TP(const float, 11) + (size_t)l * RANK * GK; const float* a_bias = TP(const float, 12) + (size_t)l * GK;
    float* NPP = outp + O_NPP + (size_t)l * NB * PBUF * PW; float* NPS = outp + O_NPS + (size_t)l * DECB * PBUF * PW;
    for (int it = gw; it < 4096; it += NGW) {
        const bool samp = it >= 2048; const int r = it & 2047, cb = r & 15, cid = r >> 4;
        const int b = samp ? cid : (cid >> 5), ci = samp ? 0 : (cid & 31);
        const int t0 = samp ? MP + 8 * b : b * SEQ + 64 * ci, ntok = samp ? 8 : 64, pos0 = samp ? 0 : 64 * ci;
        const int c = 64 * cb + lane;
        float aup[16];
#pragma unroll
        for (int j = 0; j < 16; ++j) aup[j] = a_up[j * GK + c];
        const float ab = a_bias[c];
        float alo[16];
        { const int tr = lane < ntok ? lane : ntok - 1; const GAS f32x4* ap = (const GAS f32x4*)(ALO + (size_t)(t0 + tr) * 16);
#pragma unroll
          for (int j = 0; j < 4; ++j) { const f32x4 v = ap[j]; alo[4 * j] = v.x; alo[4 * j + 1] = v.y; alo[4 * j + 2] = v.z; alo[4 * j + 3] = v.w; } }
        const int w = 2 << (c >> 8);
        float wsum = 0.f;
        for (int j = 1; j < w; ++j) { const int p = pos0 - j;
            float e;
            if (p >= 0) e = bf2f(HQ[(size_t)(t0 - j) * 3072 + c]);
            else e = samp ? state_pool[((size_t)b * PBUF + (PBUF + p)) * PW + c] : 0.f;
            wsum += e; }
        if (samp) { for (int j = 0; j < 7; ++j) NPS[((size_t)b * PBUF + j) * PW + c] = state_pool[((size_t)b * PBUF + 8 + j) * PW + c]; }
        float bs = 0.f;
#pragma unroll 1
        for (int tb = 0; tb < ntok; tb += 8) {
            float uu[8], qq[8], kk[8], uo[8];
#pragma unroll
            for (int j = 0; j < 8; ++j) { const size_t row = (size_t)(t0 + tb + j);
                uu[j] = bf2f(HQ[row * 3072 + c]); qq[j] = bf2f(HQ[row * 3072 + 1024 + c]); kk[j] = bf2f(HQ[row * 3072 + 2048 + c]);
                const int p = pos0 + tb + j - w + 1;
                if (p >= 0) uo[j] = bf2f(HQ[(size_t)(t0 + tb + j - w + 1) * 3072 + c]);
                else uo[j] = samp ? state_pool[((size_t)b * PBUF + (PBUF + p)) * PW + c] : 0.f; }
#pragma unroll
            for (int j = 0; j < 8; ++j) { const int t = tb + j;
                float z = ab;
#pragma unroll
                for (int r = 0; r < 16; ++r) z += __uint_as_float(__builtin_amdgcn_readlane(__float_as_uint(alo[r]), t)) * aup[r];
                const float la = -(fmaxf(-z, 0.f) + log1pf(__expf(-fabsf(z)))) * 0.0625f;
                bs += la;
                const size_t row = (size_t)(t0 + t);
                const float uq = uu[j], qv = qq[j], kv = kk[j];
                const float eb = __expf(bs), enb = __expf(-bs);
                QT[row * 1024 + c] = (bf16)f2bf(qv * eb);
                const float kt = kv * enb;
                KT[row * 1024 + c] = (bf16)f2bf(kt);
                tile[lane * 65 + t] = kt;
                wsum += uq;
                const int pos = pos0 + t; const float cnt = samp ? (float)w : (float)(pos + 1 < w ? pos + 1 : w);
                PO[row * 1024 + c] = (bf16)f2bf(wsum / cnt - uq);
                wsum -= uo[j];
                if (samp) NPS[((size_t)b * PBUF + 7 + t) * PW + c] = uq;
                else if (ci == 31 && t >= 49) NPP[((size_t)b * PBUF + (t - 49)) * PW + c] = uq;
            }
        }
        const float gl = __expf(bs);
        GD[(size_t)((samp ? 128 : 0) + cid) * 1024 + c] = gl;
        LDS_WAIT(); asm volatile("" ::: "memory");
        const int tg = lane & 7;
#pragma unroll
        for (int i = 0; i < 8; ++i) { const int ch = 8 * i + (lane >> 3); const float gch = __shfl(gl, ch);
            if (8 * tg < ntok) { const LAS float* s = tile + ch * 65 + 8 * tg;
                v4u o; o.x = pk2(s[0] * gch, s[1] * gch); o.y = pk2(s[2] * gch, s[3] * gch); o.z = pk2(s[4] * gch, s[5] * gch); o.w = pk2(s[6] * gch, s[7] * gch);
                *(GAS v4u*)(KHT + (size_t)(64 * cb + ch) * M + t0 + 8 * tg) = o; } }
        LDS_WAIT(); asm volatile("" ::: "memory");
    }
}

#define BAR_LDS() do { asm volatile("s_waitcnt lgkmcnt(0)" ::: "memory"); __builtin_amdgcn_s_barrier(); asm volatile("" ::: "memory"); } while (0)
constexpr int GL_QS = 0, GL_ROW = 528, GL_KT = GL_QS + 64 * GL_ROW, GL_KH = GL_KT + 64 * GL_ROW, GL_KH_STRIDE = 144, GL_AL = GL_KH + 256 * GL_KH_STRIDE, GL_AL_STRIDE = 144,
              GL_G = GL_AL + 64 * GL_AL_STRIDE, GL_END = GL_G + 1024;
static_assert(GL_END <= RING_BYTES, "GLA LDS");
__device__ __forceinline__ void gla_prompt_unit(Frame& F, int l, int u) {
    PHASE_IDS;
    unsigned char* const ws = TP(unsigned char, 17);
    const int b = u >> 4, h = (u >> 2) & 3, vq = u & 3, w = wave_o, lane = lane_o, l15 = lane & 15, q = lane >> 4, tid = tid_o;
    const bf16* QT = (const bf16*)(ws + WS_QT); const bf16* KT = (const bf16*)(ws + WS_KT); const bf16* KHT = (const bf16*)(ws + WS_KHT); const bf16* VT = (const bf16*)(ws + WS_VT);
    const float* GD = (const float*)(ws + WS_GDEC); float* ORAW = (float*)(ws + WS_ORAW);
    const int vcol0 = h * 512 + vq * 128 + 16 * w;
    LAS unsigned char* lds = LDSB;
    f32x4 S[16];
#pragma unroll
    for (int i = 0; i < 16; ++i) S[i] = (f32x4){0.f, 0.f, 0.f, 0.f};
    v4u rq[4], rk[4], rh[4]; f32x4 rg = (f32x4){0.f, 0.f, 0.f, 0.f}; bf16x8 vfn[2];
#define GLP_LOAD(CI) do { const int t0n = b * SEQ + 64 * (CI); \
        _Pragma("unroll") for (int i = 0; i < 4; ++i) { const int p = tid + 512 * i, row = p >> 5, cs = p & 31; \
            rq[i] = *(const GAS v4u*)(QT + (size_t)(t0n + row) * 1024 + h * 256 + cs * 8); rk[i] = *(const GAS v4u*)(KT + (size_t)(t0n + row) * 1024 + h * 256 + cs * 8); } \
        _Pragma("unroll") for (int i = 0; i < 4; ++i) { const int p = tid + 512 * i, row = p >> 3, cs = p & 7; \
            rh[i] = *(const GAS v4u*)(KHT + (size_t)(h * 256 + row) * M + t0n + cs * 8); } \
        if (tid < 64) rg = *(const GAS f32x4*)(GD + (size_t)(b * 32 + (CI)) * 1024 + h * 256 + 4 * tid); \
        _Pragma("unroll") for (int s = 0; s < 2; ++s) vfn[s] = *(const GAS bf16x8*)(VT + (size_t)(vcol0 + l15) * M + t0n + 32 * s + 8 * q); } while (0)
    GLP_LOAD(0);
#pragma unroll 1
    for (int ci = 0; ci < 32; ++ci) {
        const int t0 = b * SEQ + 64 * ci;
        BAR_LDS();
#pragma unroll
        for (int i = 0; i < 4; ++i) { const int p = tid + 512 * i, row = p >> 5, cs = p & 31;
            *(LAS v4u*)(lds + GL_QS + row * GL_ROW + cs * 16) = rq[i]; *(LAS v4u*)(lds + GL_KT + row * GL_ROW + cs * 16) = rk[i]; }
#pragma unroll
        for (int i = 0; i < 4; ++i) { const int p = tid + 512 * i, row = p >> 3, cs = p & 7; *(LAS v4u*)(lds + GL_KH + row * GL_KH_STRIDE + cs * 16) = rh[i]; }
        if (tid < 64) *(LAS f32x4*)(lds + GL_G + 16 * tid) = rg;
        bf16x8 vf[2]; vf[0] = vfn[0]; vf[1] = vfn[1];
        if (ci + 1 < 32) GLP_LOAD(ci + 1);
        BAR_LDS();
        {
            const int it = w >> 1;
#pragma unroll
            for (int jj = 0; jj < 2; ++jj) { const int jt = 2 * (w & 1) + jj;
                f32x4 acc = (f32x4){0.f, 0.f, 0.f, 0.f};
                if (jt <= it) {
#pragma unroll
                    for (int sh = 0; sh < 2; ++sh) {
                        bf16x8 af[4], bfr[4];
#pragma unroll
                        for (int s = 0; s < 4; ++s) { af[s] = *(const LAS bf16x8*)(lds + GL_QS + (16 * it + l15) * GL_ROW + (32 * (4 * sh + s) + 8 * q) * 2);
                            bfr[s] = *(const LAS bf16x8*)(lds + GL_KT + (16 * jt + l15) * GL_ROW + (32 * (4 * sh + s) + 8 * q) * 2); }
                        __builtin_amdgcn_sched_barrier(0);
#pragma unroll
                        for (int s = 0; s < 4; ++s) acc = __builtin_amdgcn_mfma_f32_16x16x32_bf16(af[s], bfr[s], acc, 0, 0, 0);
                        __builtin_amdgcn_sched_barrier(0);
                    }
                }
#pragma unroll
                for (int r = 0; r < 4; ++r) { const int i = 16 * it + 4 * q + r, j = 16 * jt + l15; const float v = (j <= i) ? acc[r] : 0.f;
                    *(LAS bf16*)(lds + GL_AL + i * GL_AL_STRIDE + j * 2) = (bf16)f2bf(v); }
            }
        }
        BAR_LDS();
        f32x4 oT[4];
#pragma unroll
        for (int it = 0; it < 4; ++it) oT[it] = (f32x4){0.f, 0.f, 0.f, 0.f};
        {
            v2u qlo[2][4], qhi[2][4];
#define GLP_QF(buf, s) do { _Pragma("unroll") for (int it = 0; it < 4; ++it) { const LAS unsigned char* qp = lds + GL_QS + (16 * it + l15) * GL_ROW + (32 * (s) + 4 * q) * 2; \
                qlo[buf][it] = *(const LAS v2u*)qp; qhi[buf][it] = *(const LAS v2u*)(qp + 32); } } while (0)
            GLP_QF(0, 0);
#pragma unroll
            for (int s = 0; s < 8; ++s) {
                if (s + 1 < 8) GLP_QF((s + 1) & 1, s + 1);
                __builtin_amdgcn_sched_barrier(0);
                bf16x8 sf; { const f32x4 x0 = S[2 * s], x1 = S[2 * s + 1]; v4u wv; wv.x = pk2(x0[0], x0[1]); wv.y = pk2(x0[2], x0[3]); wv.z = pk2(x1[0], x1[1]); wv.w = pk2(x1[2], x1[3]); sf = __builtin_bit_cast(bf16x8, wv); }
#pragma unroll
                for (int it = 0; it < 4; ++it) {
                    const bf16x8 qf = __builtin_bit_cast(bf16x8, (v4u){qlo[s & 1][it].x, qlo[s & 1][it].y, qhi[s & 1][it].x, qhi[s & 1][it].y});
                    oT[it] = __builtin_amdgcn_mfma_f32_16x16x32_bf16(sf, qf, oT[it], 0, 0, 0);
                }
                __builtin_amdgcn_sched_barrier(0);
            }
#undef GLP_QF
        }
        {
            bf16x8 af[2][4];
#pragma unroll
            for (int s = 0; s < 2; ++s)
#pragma unroll
                for (int it = 0; it < 4; ++it) af[s][it] = *(const LAS bf16x8*)(lds + GL_AL + (16 * it + l15) * GL_AL_STRIDE + (32 * s + 8 * q) * 2);
            __builtin_amdgcn_sched_barrier(0);
#pragma unroll
            for (int s = 0; s < 2; ++s)
#pragma unroll
                for (int it = 0; it < 4; ++it) oT[it] = __builtin_amdgcn_mfma_f32_16x16x32_bf16(vf[s], af[s][it], oT[it], 0, 0, 0);
        }
#pragma unroll
        for (int it = 0; it < 4; ++it) *(GAS f32x4*)(ORAW + (size_t)(t0 + 16 * it + l15) * 2048 + vcol0 + 4 * q) = oT[it];
        {
            bf16x8 kf[2][2][2]; f32x4 gv[2][2];
#define GLP_KF(buf, kg) do { _Pragma("unroll") for (int kk = 0; kk < 2; ++kk) { const int kt = 2 * (kg) + kk; gv[buf][kk] = *(const LAS f32x4*)(lds + GL_G + (16 * kt + 4 * q) * 4); \
                _Pragma("unroll") for (int s = 0; s < 2; ++s) kf[buf][kk][s] = *(const LAS bf16x8*)(lds + GL_KH + (16 * kt + l15) * GL_KH_STRIDE + (32 * s + 8 * q) * 2); } } while (0)
            GLP_KF(0, 0);
#pragma unroll
            for (int kg = 0; kg < 8; ++kg) {
                if (kg + 1 < 8) GLP_KF((kg + 1) & 1, kg + 1);
                __builtin_amdgcn_sched_barrier(0);
#pragma unroll
                for (int kk = 0; kk < 2; ++kk) { const int kt = 2 * kg + kk;
                    f32x4 acc = S[kt] * gv[kg & 1][kk];
#pragma unroll
                    for (int s = 0; s < 2; ++s) acc = __builtin_amdgcn_mfma_f32_16x16x32_bf16(kf[kg & 1][kk][s], vf[s], acc, 0, 0, 0);
                    S[kt] = acc; }
                __builtin_amdgcn_sched_barrier(0);
            }
#undef GLP_KF
        }
    }
#undef GLP_LOAD
    float* NG = TP(float, 16) + O_NGP + ((size_t)((l * NB + b) * GH + h) * DK) * DV;
#pragma unroll
    for (int kt = 0; kt < 16; ++kt)
#pragma unroll
        for (int r = 0; r < 4; ++r) NG[(size_t)(16 * kt + 4 * q + r) * DV + vq * 128 + 16 * w + l15] = S[kt][r];
    BAR_LDS();
}

constexpr int GS_REC = 0, GS_REC_STRIDE = 20  , GS_A = 256 * GS_REC_STRIDE * 4, GS_KT = GS_A + 64 * 4, GS_RED = GS_KT + 8 * 257 * 4, GS_END = GS_RED + 4 * 8 * 512 * 4;
static_assert(GS_END <= RING_BYTES, "GLA sample LDS");
__device__ __forceinline__ void gla_sample_unit(Frame& F, int l, int u) {
    PHASE_IDS;
    unsigned char* const ws = TP(unsigned char, 17);
    const int b = u >> 2, h = u & 3, tid = tid_o;
    const bf16* QT = (const bf16*)(ws + WS_QT); const bf16* KT = (const bf16*)(ws + WS_KT); const bf16* KHT = (const bf16*)(ws + WS_KHT); const bf16* VT = (const bf16*)(ws + WS_VT);
    const float* GD = (const float*)(ws + WS_GDEC); float* ORAW = (float*)(ws + WS_ORAW);
    const float* S0 = TP(const float, 3) + ((size_t)((l * DECB + b) * GH + h) * DK) * DV; float* S1 = TP(float, 16) + O_NGS + ((size_t)((l * DECB + b) * GH + h) * DK) * DV;
    LAS float* rec = (LAS float*)(LDSB + GS_REC);
    LAS float* Am = (LAS float*)(LDSB + GS_A);
    LAS float* kts = (LAS float*)(LDSB + GS_KT);
    LAS float* red = (LAS float*)(LDSB + GS_RED);
    const int row0 = MP + 8 * b;
    const int c4 = tid & 127, kq = tid >> 7;
    const GAS f32x4* sp = (const GAS f32x4*)(S0 + (size_t)(64 * kq) * DV) + c4; GAS f32x4* dp = (GAS f32x4*)(S1 + (size_t)(64 * kq) * DV) + c4;
    f32x4 cur[8], nxt[8];
#pragma unroll
    for (int j = 0; j < 8; ++j) cur[j] = __builtin_nontemporal_load(sp + (size_t)j * (DV / 4));
    __syncthreads();
    { const int i = tid >> 6, k4 = (tid & 63) * 4;
      const v2u qw = *(const GAS v2u*)(QT + (size_t)(row0 + i) * 1024 + h * 256 + k4); const v2u kw = *(const GAS v2u*)(KT + (size_t)(row0 + i) * 1024 + h * 256 + k4);
      rec[(k4 + 0) * GS_REC_STRIDE + i] = pg8::bf_lo(qw.x); rec[(k4 + 1) * GS_REC_STRIDE + i] = pg8::bf_hi(qw.x); rec[(k4 + 2) * GS_REC_STRIDE + i] = pg8::bf_lo(qw.y); rec[(k4 + 3) * GS_REC_STRIDE + i] = pg8::bf_hi(qw.y);
      kts[i * 257 + k4 + 0] = pg8::bf_lo(kw.x); kts[i * 257 + k4 + 1] = pg8::bf_hi(kw.x); kts[i * 257 + k4 + 2] = pg8::bf_lo(kw.y); kts[i * 257 + k4 + 3] = pg8::bf_hi(kw.y); }
    if (tid < 256) { const int k = tid; const v4u kh = *(const GAS v4u*)(KHT + (size_t)(h * 256 + k) * M + row0);
      LAS float* rp = rec + k * GS_REC_STRIDE + 8;
      rp[0] = pg8::bf_lo(kh.x); rp[1] = pg8::bf_hi(kh.x); rp[2] = pg8::bf_lo(kh.y); rp[3] = pg8::bf_hi(kh.y); rp[4] = pg8::bf_lo(kh.z); rp[5] = pg8::bf_hi(kh.z); rp[6] = pg8::bf_lo(kh.w); rp[7] = pg8::bf_hi(kh.w);
      rp[8] = GD[(size_t)(128 + b) * 1024 + h * 256 + k]; }
    float vv[8][4];
#pragma unroll
    for (int e = 0; e < 4; ++e) { const v4u t = *(const GAS v4u*)(VT + (size_t)(h * 512 + 4 * c4 + e) * M + row0);
        vv[0][e] = pg8::bf_lo(t.x); vv[1][e] = pg8::bf_hi(t.x); vv[2][e] = pg8::bf_lo(t.y); vv[3][e] = pg8::bf_hi(t.y); vv[4][e] = pg8::bf_lo(t.z); vv[5][e] = pg8::bf_hi(t.z); vv[6][e] = pg8::bf_lo(t.w); vv[7][e] = pg8::bf_hi(t.w); }
    __syncthreads();
    if (tid < 64) { const int i = tid >> 3, j = tid & 7; float s = 0.f;
      if (j <= i) for (int k = 0; k < 256; ++k) s += rec[k * GS_REC_STRIDE + i] * kts[j * 257 + k];
      Am[tid] = s; }
    f32x4 o[8];
#pragma unroll
    for (int i = 0; i < 8; ++i) o[i] = (f32x4){0.f, 0.f, 0.f, 0.f};
#pragma unroll 1
    for (int kb = 0; kb < 8; ++kb) {
        if (kb + 1 < 8) {
#pragma unroll
            for (int j = 0; j < 8; ++j) nxt[j] = __builtin_nontemporal_load(sp + (size_t)(8 * (kb + 1) + j) * (DV / 4));
        }
#pragma unroll
        for (int j = 0; j < 8; ++j) {
            const int kk = 8 * kb + j; const f32x4 s0 = cur[j];
            const LAS f32x4* rp = (const LAS f32x4*)(rec + (64 * kq + kk) * GS_REC_STRIDE);
            const f32x4 q0 = rp[0], q1 = rp[1], k0 = rp[2], k1 = rp[3]; const float g = rec[(64 * kq + kk) * GS_REC_STRIDE + 16];
            f32x4 sn = s0 * g;
#pragma unroll
            for (int jj = 0; jj < 4; ++jj) { const f32x4 v = (f32x4){vv[jj][0], vv[jj][1], vv[jj][2], vv[jj][3]}; sn += v * k0[jj]; }
#pragma unroll
            for (int jj = 0; jj < 4; ++jj) { const f32x4 v = (f32x4){vv[4 + jj][0], vv[4 + jj][1], vv[4 + jj][2], vv[4 + jj][3]}; sn += v * k1[jj]; }
#pragma unroll
            for (int i = 0; i < 4; ++i) { o[i] += s0 * q0[i]; o[4 + i] += s0 * q1[i]; }
            __builtin_nontemporal_store(sn, dp + (size_t)kk * (DV / 4));
        }
#pragma unroll
        for (int j = 0; j < 8; ++j) cur[j] = nxt[j];
    }
#pragma unroll
    for (int i = 0; i < 8; ++i) *(LAS f32x4*)(red + ((kq * 8 + i) * 512 + 4 * c4)) = o[i];
    __syncthreads();
#pragma unroll
    for (int rr = 0; rr < 2; ++rr) { const int idx = tid + 512 * rr, i = idx >> 7, cg = idx & 127;
        f32x4 acc = *(const LAS f32x4*)(red + ((0 * 8 + i) * 512 + 4 * cg)) + *(const LAS f32x4*)(red + ((1 * 8 + i) * 512 + 4 * cg)) + *(const LAS f32x4*)(red + ((2 * 8 + i) * 512 + 4 * cg)) + *(const LAS f32x4*)(red + ((3 * 8 + i) * 512 + 4 * cg));
#pragma unroll
        for (int j = 0; j < 8; ++j) { const float aij = (j <= i) ? Am[i * 8 + j] : 0.f; acc += (f32x4){vv[j][0], vv[j][1], vv[j][2], vv[j][3]} * aij; }
        *(GAS f32x4*)(ORAW + (size_t)(row0 + i) * 2048 + h * 512 + 4 * cg) = acc; }
}

__device__ __forceinline__ void postnorm_phase(Frame& F, int l) {
    PHASE_IDS;
    unsigned char* const ws = TP(unsigned char, 17);
    const int gw = BID * NWAVES + wave_o, NGW = GRID * NWAVES, lane = lane_o;
    const float* ORAW = (const float*)(ws + WS_ORAW); const bf16* HR = (const bf16*)(ws + WS_HR); bf16* OG = (bf16*)(ws + WS_OG); const float* hg = TP(const float, 13) + (size_t)l * GV;
    for (int m = gw; m < M; m += NGW) {
        const GAS f32x4* orow = (const GAS f32x4*)(ORAW + (size_t)m * 2048);
        f32x4 v[8]; float rs[4];
#pragma unroll
        for (int hh = 0; hh < 4; ++hh) { v[2 * hh] = orow[hh * 128 + lane]; v[2 * hh + 1] = orow[hh * 128 + 64 + lane];
            float s = 0.f;
#pragma unroll
            for (int e = 0; e < 4; ++e) s += v[2 * hh][e] * v[2 * hh][e] + v[2 * hh + 1][e] * v[2 * hh + 1][e];
            rs[hh] = 1.f / sqrtf(wave_sum(s) * (1.f / 512.f) + HN_EPS); }
#pragma unroll
        for (int j = 0; j < 8; ++j) { const int col = (j >> 1) * 512 + (j & 1) * 256 + 4 * lane;
            const f32x4 g4 = *(const f32x4*)(hg + col); const v2u rw = *(const GAS v2u*)(HR + (size_t)m * 6144 + col);
            const f32x4 x = v[j] * rs[j >> 1] * g4;
            *(GAS v2u*)(OG + (size_t)m * 2048 + col) = (v2u){pk2(x[0] * pg8::bf_lo(rw.x), x[1] * pg8::bf_hi(rw.x)), pk2(x[2] * pg8::bf_lo(rw.y), x[3] * pg8::bf_hi(rw.y))}; }
    }
}

constexpr int N_PHASES = 22;
#ifndef REP_P0
#define REP_P0 1
#endif
#ifndef REP_FFI
#define REP_FFI 1
#endif
#ifndef REP_FFO
#define REP_FFO 1
#endif
#ifndef REP_LN
#define REP_LN 1
#endif
#ifndef REP_MIXIN
#define REP_MIXIN 1
#endif
#ifndef REP_PRE
#define REP_PRE 1
#endif
#ifndef REP_GLA
#define REP_GLA 1
#endif
#ifndef REP_POST
#define REP_POST 1
#endif
#ifndef REP_GLAP
#define REP_GLAP 1
#endif
#ifndef REP_GLAS
#define REP_GLAS 1
#endif
#ifndef REP_GO
#define REP_GO 1
#endif
#ifndef REP_WO
#define REP_WO 1
#endif
#define WSP(T, off) ((T*)(TP(unsigned char, 17) + (off)))
__global__ void __launch_bounds__(NWAVES * 64, 2) mega_fwd(Args args) {
    Frame F;
    for (int u = TID; u < (LDS_BYTES - LDSCTL_OFF) / 4; u += NWAVES * 64) ((LAS unsigned*)(LDSB + LDSCTL_OFF))[u] = 0u;
    __syncthreads();
    if (TID == 0) {
        LAS unsigned long long* tab = (LAS unsigned long long*)(LDSB + TAB_OFF);
#pragma unroll
        for (int i = 0; i < 16; ++i) tab[i] = (unsigned long long)args.in[i];
        tab[16] = (unsigned long long)args.out; tab[17] = (unsigned long long)args.ws;
    }
    const int lo = args.ph_lo, hi = args.ph_hi;
    __syncthreads();
    if (hi - lo > 1) (void)xcd_barrier_post(WSP(unsigned, WS_CTL) + CW_BAR, (volatile LAS unsigned*)(LDSB + MISC_OFF) + 8);
#define IN(k) (lo <= (k) && (k) < hi)
#define GRIDBAR() do { XcdBarrier bar_; bar_.bar = WSP(unsigned, WS_CTL) + CW_BAR; bar_.x = xb_xcc_id(); bar_.st = (volatile LAS unsigned*)(LDSB + MISC_OFF) + 8; xcd_barrier(bar_); } while (0)
#define REPEAT(n) _Pragma("unroll 1") for (int rep_ = 0; rep_ < (n); ++rep_)
#define REPBAR() do { if (rep_) GRIDBAR(); } while (0)
#define SEAM(k) do { if (IN(k) && IN((k) + 1)) { XcdBarrier bar_; bar_.bar = WSP(unsigned, WS_CTL) + CW_BAR; bar_.x = xb_xcc_id(); bar_.st = (volatile LAS unsigned*)(LDSB + MISC_OFF) + 8; xcd_barrier(bar_); } } while (0)
    int ph = 0;
#ifndef SKIP_P0
    if (IN(ph)) REPEAT(REP_P0) { REPBAR(); p0_prologue(F); }
#endif
    SEAM(ph); ++ph;
#pragma unroll 1
    for (int l = 0; l < 2; ++l) {
#pragma unroll 1
        for (int f = 0; f < 2; ++f) {
            const bool first = (l == 0 && f == 0);
            if (IN(ph)) REPEAT(REP_FFI) { REPBAR();
#ifndef SKIP_FFI
                const int s_in = (f == 0) ? 3 * l - 1 : 3 * l + 1;
                pg8::Gemm g{first ? WSP(const bf16, WS_XB) : WSP(const bf16, WS_YB), WSP(const bf16, WS_WFI + (size_t)(l * 2 + f) * SZ_WFI), M, FF2, D, D, D, 31, 0};
                pg8::StaticOrder S; S.init(M, FF2, GRID, BID);
                pg8::LnFold L{first ? nullptr : WSP(const float, WS_STAT + (size_t)(first ? 0 : s_in) * SZ_STAT),
                              first ? WSP(const float, WS_ZERO) : WSP(const float, WS_CFI + (size_t)(l * 2 + f) * 2 * SZ_CFI),
                              first ? WSP(const float, WS_ZERO) : WSP(const float, WS_CFI + (size_t)(l * 2 + f) * 2 * SZ_CFI + SZ_CFI)};
                pg8::EpiSwiGLU E{WSP(bf16, WS_ACT), FF, L};
                pg8::gemm_phase<pg8::EpiSwiGLU, pg8::StaticOrder>(LDSB, g, S, E);
#endif
            } SEAM(ph); ++ph;
            if (IN(ph)) REPEAT(REP_FFO) { REPBAR();
#ifndef SKIP_FFO
                const int s_out = (f == 0) ? 3 * l : 3 * l + 2;
                pg8::Gemm g{WSP(const bf16, WS_ACT), WSP(const bf16, WS_WFO + (size_t)(l * 2 + f) * SZ_WFO), M, D, FF, FF, FF, 31, 0};
                pg8::StaticOrder S; S.init(M, D, GRID, BID);
                pg8::EpiResid E{WSP(float, WS_Y), WSP(bf16, WS_YB), WSP(float, WS_STAT + (size_t)s_out * SZ_STAT), TP(const float, 0), TP(const float, 1), MP,
                                first ? nullptr : WSP(const float, WS_STAT + (size_t)(first ? 0 : s_out - 1) * SZ_STAT), TP(const float, 4) + (size_t)(first ? 0 : s_out - 1) * D, TP(const float, 5) + (size_t)(first ? 0 : s_out - 1) * D,
                                ALPHA, 0.5f};
                pg8::gemm_phase<pg8::EpiResid, pg8::StaticOrder>(LDSB, g, S, E);
#endif
            } SEAM(ph); ++ph;
            if (f == 0) {
                if (IN(ph)) REPEAT(REP_MIXIN) { REPBAR();
                    const float* st = WSP(const float, WS_STAT + (size_t)(3 * l) * SZ_STAT);
                    const float* cm1 = WSP(const float, WS_CMIX + (size_t)l * 2 * SZ_CMIX); const float* cm2 = cm1 + (3328 + 6144 + 2048);
#ifndef SKIP_UQKA
                    { pg8::Gemm g{WSP(const bf16, WS_YB), WSP(const bf16, WS_WUQKA + (size_t)l * SZ_WUQKA), M, 3328, D, D, D, 31, 0};
                      pg8::StaticOrder S; S.init(M, 3328, GRID, BID);
                      pg8::EpiUqka E{WSP(bf16, WS_HQ), WSP(float, WS_ALO), pg8::LnFold{st, cm1, cm2}};
                      pg8::gemm_phase<pg8::EpiUqka, pg8::StaticOrder>(LDSB, g, S, E); }
#endif
#ifndef SKIP_RGG
                    { pg8::Gemm g{WSP(const bf16, WS_YB), WSP(const bf16, WS_WRGG + (size_t)l * SZ_WRGG), M, 6144, D, D, D, 31, 0};
                      pg8::StaticOrder S; S.init(M, 6144, GRID, (BID + GRID - 208) % GRID);
                      pg8::EpiRgg E{WSP(bf16, WS_HR), pg8::LnFold{st, cm1 + 3328, cm2 + 3328}};
                      pg8::gemm_phase<pg8::EpiRgg, pg8::StaticOrder>(LDSB, g, S, E); }
#endif
#ifndef SKIP_VT
                    { pg8::Gemm g{WSP(const bf16, WS_WV + (size_t)l * SZ_WV), WSP(const bf16, WS_YB), D, M, D, D, D, 31, 0};
                      pg8::StaticOrder S; S.init(D, M, GRID, (BID + GRID - 48) % GRID);
                      pg8::EpiVT E{WSP(bf16, WS_VT), M, pg8::LnFold{st, cm1 + 3328 + 6144, cm2 + 3328 + 6144}};
                      pg8::gemm_phase<pg8::EpiVT, pg8::StaticOrder>(LDSB, g, S, E); }
#endif
                } SEAM(ph); ++ph;
#ifndef SKIP_PRE
                if (IN(ph)) REPEAT(REP_PRE) { REPBAR(); prepass_phase(F, l); }
#endif
                SEAM(ph); ++ph;
                if (IN(ph)) REPEAT(REP_GLA) { REPBAR();
#ifndef SKIP_GLAP
                    if (BID < 64) { _Pragma("unroll 1") for (int rp_ = 0; rp_ < REP_GLAP; ++rp_) gla_prompt_unit(F, l, BID); }
#endif
                    LAS unsigned* qslot = (LAS unsigned*)(LDSB + LDSCTL_OFF);
                    _Pragma("unroll 1") for (int rs_ = 0; rs_ < REP_GLAS; ++rs_)
                    for (;;) {
                        __syncthreads();
                        if (TID == 0) qslot[0] = __hip_atomic_fetch_add(WSP(unsigned, WS_CTL) + CW_QUEUE + 64 * (l + 2 * rep_ + 4 * rs_), 1u, RLX_AGENT);
                        __syncthreads();
                        const unsigned u = ((volatile LAS unsigned*)qslot)[0];
                        if (u >= 512u) break;
#ifndef SKIP_GLAS
                        gla_sample_unit(F, l, (int)u);
#endif
                    }
                } SEAM(ph); ++ph;
                if (IN(ph)) REPEAT(REP_POST) { REPBAR();
#ifndef SKIP_POSTN
                    postnorm_phase(F, l);
#endif
                    __syncthreads();
#ifndef SKIP_POOL
                    int kpool = 256; asm volatile("" : "+s"(kpool));
                    pg8::Gemm g{WSP(const bf16, WS_POOLED), WSP(const bf16, WS_WPOOL + (size_t)l * SZ_WPOOL), M, D, kpool, 1024, 256, 1, 256};
                    pg8::StaticOrder S; S.init(M, D, GRID, BID);
                    pg8::EpiPool E{WSP(bf16, WS_YA), WSP(const bf16, WS_HR), TP(const float, 10) + (size_t)l * D};
                    pg8::gemm_phase<pg8::EpiPool, pg8::StaticOrder>(LDSB, g, S, E);
#endif
                } SEAM(ph); ++ph;
                if (IN(ph)) REPEAT(REP_GO) { REPBAR();
#ifndef SKIP_GO
                    pg8::Gemm g{WSP(const bf16, WS_OG), WSP(const bf16, WS_WGO + (size_t)l * SZ_WSQ), M, D, D, D, D, 31, 0};
                    pg8::StaticOrder S; S.init(M, D, GRID, BID);
                    pg8::EpiMerge E{WSP(bf16, WS_MG), WSP(const bf16, WS_YA), WSP(const bf16, WS_HR)};
                    pg8::gemm_phase<pg8::EpiMerge, pg8::StaticOrder>(LDSB, g, S, E);
#endif
                } SEAM(ph); ++ph;
                if (IN(ph)) REPEAT(REP_WO) { REPBAR();
#ifndef SKIP_WO
                    pg8::Gemm g{WSP(const bf16, WS_MG), WSP(const bf16, WS_WO + (size_t)l * SZ_WSQ), M, D, D, D, D, 31, 0};
                    pg8::StaticOrder S; S.init(M, D, GRID, BID);
                    pg8::EpiResid E{WSP(float, WS_Y), WSP(bf16, WS_YB), WSP(float, WS_STAT + (size_t)(3 * l + 1) * SZ_STAT), TP(const float, 0), TP(const float, 1), MP,
                                    WSP(const float, WS_STAT + (size_t)(3 * l) * SZ_STAT), TP(const float, 4) + (size_t)(3 * l) * D, TP(const float, 5) + (size_t)(3 * l) * D, ALPHA, 1.0f};
                    pg8::gemm_phase<pg8::EpiResid, pg8::StaticOrder>(LDSB, g, S, E);
#endif
                } SEAM(ph); ++ph;
            }
        }
    }
#ifndef SKIP_LN
    if (IN(ph)) REPEAT(REP_LN) { REPBAR(); ln_phase(F, WSP(const float, WS_Y), TP(const float, 4) + (size_t)5 * D, TP(const float, 5) + (size_t)5 * D, TP(float, 16) + O_Y, nullptr); }
#endif
    ++ph;
#undef IN
#undef SEAM
}

extern "C" void kernel_launch(void* const* d_in, const int* in_sizes, int n_in, void* d_out, int out_size, void* d_ws, size_t ws_size, hipStream_t stream) {
    static int grid = 0;
    if (grid == 0) {
        if (n_in != 16 || (size_t)out_size != O_END || ws_size < WS_END) { fprintf(stderr, "kernel_launch: unexpected shapes (n_in %d out %d ws %zu need %zu)\n", n_in, out_size, ws_size, (size_t)WS_END); grid = -1; return; }
        int dev = 0, cus = 0, per_cu = 0;
        if (hipGetDevice(&dev) != hipSuccess || hipDeviceGetAttribute(&cus, hipDeviceAttributeMultiprocessorCount, dev) != hipSuccess) { grid = -1; return; }
        if (hipFuncSetAttribute((const void*)mega_fwd, hipFuncAttributeMaxDynamicSharedMemorySize, LDS_BYTES) != hipSuccess) { fprintf(stderr, "kernel_launch: hipFuncSetAttribute failed\n"); grid = -1; return; }
        if (hipOccupancyMaxActiveBlocksPerMultiprocessor(&per_cu, (const void*)mega_fwd, NWAVES * 64, LDS_BYTES) != hipSuccess || per_cu < 1)
            fprintf(stderr, "kernel_launch: occupancy query reports %d workgroups per CU\n", per_cu);
        (void)hipGetLastError();
        grid = cus;
    }
    if (grid < 0) return;
    if (hipMemsetAsync((char*)d_ws + WS_CTL, 0, CTL_ZERO_BYTES, stream) != hipSuccess) return;
    Args a{};
    for (int i = 0; i < 16; ++i) a.in[i] = (const float*)d_in[i];
    a.out = (float*)d_out; a.ws = (unsigned char*)d_ws;
#if MK_PER_PHASE
    for (int p = 0; p < N_PHASES; ++p) { a.ph_lo = p; a.ph_hi = p + 1; hipLaunchKernelGGL(mega_fwd, dim3(grid), dim3(NWAVES * 64), LDS_BYTES, stream, a); }
#else
    a.ph_lo = 0; a.ph_hi = N_PHASES;
    hipLaunchKernelGGL(mega_fwd, dim3(grid), dim3(NWAVES * 64), LDS_BYTES, stream, a);
#endif
}
```
